# Optimizing an MI355X kernel written in HIP

```python
import jax, jax.numpy as jnp
from jax import lax
import numpy as np

D_MODEL = 1024
BATCH = 2
SEQ = 8192
DEPTH = 2

GRID_W = 64
CTX_LEN = 256
EPS = 1e-6

ATT_HEADS = 8
ATT_KV_HEADS = 2
ATT_GROUP = ATT_HEADS // ATT_KV_HEADS
HEAD_DIM = 64
ATT_WIDTH = ATT_HEADS * HEAD_DIM
KV_WIDTH = ATT_KV_HEADS * HEAD_DIM
Q_BLOCK = 128
ROPE_THETA = 10000.0

LRU_WIDTH = 256
LRU_BLOCKS = 4
LRU_BLOCK_DIM = LRU_WIDTH // LRU_BLOCKS
LRU_CONV = 4
LRU_C = 8.0

DN_HEADS = 4
DN_HEAD_DIM = 64
DN_WIDTH = DN_HEADS * DN_HEAD_DIM
DN_CONV = 4
DN_CHUNK = 64

N_DIR = 2
MIX_WIDTH = ATT_WIDTH + LRU_WIDTH + DN_WIDTH
FFN_HIDDEN = ((8 * D_MODEL + 3 * 256 - 1) // (3 * 256)) * 256

SPLIT_SIZES = (ATT_WIDTH, KV_WIDTH, KV_WIDTH, LRU_WIDTH, LRU_WIDTH, 3 * DN_WIDTH, DN_WIDTH, N_DIR * DN_HEADS, N_DIR * DN_HEADS)
SPLIT_AT = tuple(int(v) for v in np.cumsum(SPLIT_SIZES)[:-1])
IN_COLS = sum(SPLIT_SIZES)

kernel_name = 'hybrid_parallel_groups_flow_block'


def rmsnorm(x, gain):
    xf = x.astype(jnp.float32)
    y = xf * lax.rsqrt(jnp.mean(xf * xf, axis=-1, keepdims=True) + EPS)
    return (y * gain.astype(jnp.float32)).astype(x.dtype)


def l2norm(x):
    xf = x.astype(jnp.float32)
    return xf * lax.rsqrt(jnp.sum(xf * xf, axis=-1, keepdims=True) + EPS)


def axial_rope(rows):
    t = jnp.arange(rows * GRID_W)
    row = (t // GRID_W).astype(jnp.float32)
    col = (t % GRID_W).astype(jnp.float32)
    n_freq = HEAD_DIM // 4
    inv_freq = ROPE_THETA ** (-jnp.arange(n_freq, dtype=jnp.float32) / n_freq)
    ang = jnp.concatenate([row[:, None] * inv_freq, col[:, None] * inv_freq], axis=-1)
    return jnp.cos(ang), jnp.sin(ang)


def apply_rope(x, cos, sin):
    xf = x.astype(jnp.float32)
    x1, x2 = jnp.split(xf, 2, axis=-1)
    cs = cos[None, :, None, :]
    sn = sin[None, :, None, :]
    return jnp.concatenate([x1 * cs - x2 * sn, x2 * cs + x1 * sn], axis=-1).astype(x.dtype)


def dwconv_centred(x, w):
    k = w.shape[0]
    left = (k - 1) // 2
    return lax.conv_general_dilated(x, w[:, None, :].astype(x.dtype), (1,), [(left, k - 1 - left)],
                                    dimension_numbers=('NWC', 'WIO', 'NWC'), feature_group_count=x.shape[-1])


def flip_dir(t, d):
    return t[:, ::-1] if d == 1 else t


def attend(q, k, v):
    s = jnp.einsum('bqhgd,bkhd->bhgqk', q, k, preferred_element_type=jnp.float32) * HEAD_DIM ** -0.5
    p = jax.nn.softmax(s, axis=-1).astype(v.dtype)
    return jnp.einsum('bhgqk,bkhd->bqhgd', p, v)


def latent_attention(q, k_all, v_all):
    b, n = q.shape[0], q.shape[1]
    nb = n // Q_BLOCK
    qb = q.reshape(b, nb, Q_BLOCK, ATT_KV_HEADS, ATT_GROUP, HEAD_DIM).swapaxes(0, 1)
    o = lax.map(lambda blk: attend(blk, k_all, v_all), qb)
    return o.swapaxes(0, 1).reshape(b, n, ATT_WIDTH)


def linear_scan(a, u, h0):
    def combine(e, l):
        return e[0] * l[0], l[0] * e[1] + l[1]
    a_cum, h = lax.associative_scan(combine, (a, u), axis=1)
    return h + a_cum * h0[:, None, :]


def rglru(x, w_r, b_r, w_i, b_i, lam, h0):
    bsz, n, _ = x.shape
    xb = x.reshape(bsz, n, LRU_BLOCKS, LRU_BLOCK_DIM)
    r = jax.nn.sigmoid(jnp.einsum('bnkd,kde->bnke', xb, w_r).reshape(bsz, n, LRU_WIDTH) + b_r)
    i = jax.nn.sigmoid(jnp.einsum('bnkd,kde->bnke', xb, w_i).reshape(bsz, n, LRU_WIDTH) + b_i)
    log_a = -LRU_C * r * jax.nn.softplus(-lam)
    a = jnp.exp(log_a)
    mult = jnp.sqrt(-jnp.expm1(2.0 * log_a))
    h = linear_scan(a, mult * (i * x), h0)
    return h, h[:, -1]


def rglru_bidirectional(x_ctx, x_lat, w_r, b_r, w_i, b_i, lam):
    zeros = jnp.zeros((x_ctx.shape[0], LRU_WIDTH), jnp.float32)
    y_ctx, y_lat = [], []
    for d in range(N_DIR):
        h_c, s_c = rglru(flip_dir(x_ctx, d), w_r[d], b_r[d], w_i[d], b_i[d], lam[d], zeros)
        h_l, _ = rglru(flip_dir(x_lat, d), w_r[d], b_r[d], w_i[d], b_i[d], lam[d], s_c)
        y_ctx.append(flip_dir(h_c, d))
        y_lat.append(flip_dir(h_l, d))
    return y_ctx[0] + y_ctx[1], y_lat[0] + y_lat[1]


def gated_delta_chunked(q, k, v, g, beta, s0):
    bsz, n, h, dk = q.shape
    dv = v.shape[-1]
    nc = n // DN_CHUNK

    def chunks(t):
        t = t.reshape((bsz, nc, DN_CHUNK, h) + t.shape[3:])
        return jnp.moveaxis(t, 3, 1)

    q = chunks(q * dk ** -0.5)
    k = chunks(k)
    v = chunks(v)
    beta = chunks(beta)
    gc = jnp.cumsum(chunks(g), axis=-1)
    incl = jnp.tril(jnp.ones((DN_CHUNK, DN_CHUNK), dtype=bool))
    strict = jnp.tril(jnp.ones((DN_CHUNK, DN_CHUNK), dtype=bool), k=-1)
    decay = jnp.exp(jnp.where(incl, gc[..., :, None] - gc[..., None, :], -jnp.inf))
    kb = k * beta[..., None]
    lower = jnp.where(strict, jnp.einsum('bhncd,bhnkd->bhnck', kb, k) * decay, 0.0)
    eye = jnp.eye(DN_CHUNK, dtype=jnp.float32)
    rhs = jnp.concatenate([v * beta[..., None], kb * jnp.exp(gc)[..., None]], axis=-1)
    sol = lax.linalg.triangular_solve(lower + eye, rhs, left_side=True, lower=True)
    u, w = sol[..., :dv], sol[..., dv:]
    attn = jnp.where(incl, jnp.einsum('bhncd,bhnkd->bhnck', q, k) * decay, 0.0)
    q_dec = q * jnp.exp(gc)[..., None]
    k_tail = k * jnp.exp(gc[..., -1:] - gc)[..., None]
    g_tail = jnp.exp(gc[..., -1])

    def step(s, inp):
        u_c, w_c, qd_c, a_c, kt_c, gt_c = inp
        v_new = u_c - jnp.einsum('bhcd,bhde->bhce', w_c, s)
        o = jnp.einsum('bhcd,bhde->bhce', qd_c, s) + jnp.einsum('bhck,bhke->bhce', a_c, v_new)
        s = s * gt_c[..., None, None] + jnp.einsum('bhcd,bhce->bhde', kt_c, v_new)
        return s, o

    xs = tuple(jnp.moveaxis(t, 2, 0) for t in (u, w, q_dec, attn, k_tail, g_tail))
    s_fin, o = lax.scan(step, s0, xs)
    o = jnp.moveaxis(jnp.moveaxis(o, 0, 2), 1, 3).reshape(bsz, n, h, dv)
    return o, s_fin


def deltanet_bidirectional(qc, kc, vc, ac, bc, ql, kl, vl, al, bl, a_log, dt_bias):
    s0 = jnp.zeros((qc.shape[0], DN_HEADS, DN_HEAD_DIM, DN_HEAD_DIM), jnp.float32)
    o_ctx, o_lat = [], []
    for d in range(N_DIR):
        a_d = jnp.exp(a_log[d])
        g_c = -a_d * jax.nn.softplus(ac[:, :, d] + dt_bias[d])
        g_l = -a_d * jax.nn.softplus(al[:, :, d] + dt_bias[d])
        beta_c = jax.nn.sigmoid(bc[:, :, d])
        beta_l = jax.nn.sigmoid(bl[:, :, d])
        oc, s_c = gated_delta_chunked(*(flip_dir(t, d) for t in (qc, kc, vc, g_c, beta_c)), s0)
        ol, _ = gated_delta_chunked(*(flip_dir(t, d) for t in (ql, kl, vl, g_l, beta_l)), s_c)
        o_ctx.append(flip_dir(oc, d))
        o_lat.append(flip_dir(ol, d))
    return o_ctx[0] + o_ctx[1], o_lat[0] + o_lat[1]


def dn_inputs(dqkv, da, db, dn_conv_w):
    bsz, n, _ = dqkv.shape
    qkv = jax.nn.silu(dwconv_centred(dqkv, dn_conv_w).astype(jnp.float32))
    q, k, v = jnp.split(qkv.reshape(bsz, n, 3, DN_HEADS, DN_HEAD_DIM), 3, axis=2)
    q = l2norm(q[:, :, 0])
    k = l2norm(k[:, :, 0])
    a = da.astype(jnp.float32).reshape(bsz, n, N_DIR, DN_HEADS)
    b = db.astype(jnp.float32).reshape(bsz, n, N_DIR, DN_HEADS)
    return q, k, v[:, :, 0], a, b


def dn_output(o, z, g_dn_out):
    bsz, n = o.shape[0], o.shape[1]
    zf = z.astype(jnp.float32).reshape(bsz, n, DN_HEADS, DN_HEAD_DIM)
    return (rmsnorm(o, g_dn_out) * jax.nn.silu(zf)).reshape(bsz, n, DN_WIDTH).astype(z.dtype)


def merge_groups(att, lru, dn, g_group, w_out):
    y = jnp.concatenate([rmsnorm(att, g_group[:ATT_WIDTH]), rmsnorm(lru, g_group[ATT_WIDTH:]), dn], axis=-1)
    return y @ w_out


def mixer(h_lat, h_ctx, cos, sin, w_in, g_qk, lru_conv_w, lru_conv_b, lru_w_r, lru_b_r, lru_w_i, lru_b_i,
          lru_lambda, dn_conv_w, dn_a_log, dn_dt_bias, g_dn_out, g_group, w_out, need_ctx):
    bsz, n, _ = h_lat.shape
    m = h_ctx.shape[1]
    aq_l, ak_l, av_l, lg_l, lx_l, dqkv_l, dz_l, da_l, db_l = jnp.split(h_lat @ w_in, SPLIT_AT, axis=-1)
    aq_c, ak_c, av_c, lg_c, lx_c, dqkv_c, dz_c, da_c, db_c = jnp.split(h_ctx @ w_in, SPLIT_AT, axis=-1)

    q_lat = apply_rope(rmsnorm(aq_l.reshape(bsz, n, ATT_HEADS, HEAD_DIM), g_qk[0]), cos, sin)
    k_lat = apply_rope(rmsnorm(ak_l.reshape(bsz, n, ATT_KV_HEADS, HEAD_DIM), g_qk[1]), cos, sin)
    k_ctx = rmsnorm(ak_c.reshape(bsz, m, ATT_KV_HEADS, HEAD_DIM), g_qk[1])
    v_ctx = av_c.reshape(bsz, m, ATT_KV_HEADS, HEAD_DIM)
    k_all = jnp.concatenate([k_ctx, k_lat], axis=1)
    v_all = jnp.concatenate([v_ctx, av_l.reshape(bsz, n, ATT_KV_HEADS, HEAD_DIM)], axis=1)
    att_lat = latent_attention(q_lat, k_all, v_all)

    xr_lat = (dwconv_centred(lx_l, lru_conv_w) + lru_conv_b).astype(jnp.float32)
    xr_ctx = (dwconv_centred(lx_c, lru_conv_w) + lru_conv_b).astype(jnp.float32)
    y_ctx, y_lat = rglru_bidirectional(xr_ctx, xr_lat, lru_w_r, lru_b_r, lru_w_i, lru_b_i, lru_lambda)
    lru_lat = (jax.nn.gelu(lg_l.astype(jnp.float32)) * y_lat).astype(h_lat.dtype)

    ql, kl, vl, al, bl = dn_inputs(dqkv_l, da_l, db_l, dn_conv_w)
    qc, kc, vc, ac, bc = dn_inputs(dqkv_c, da_c, db_c, dn_conv_w)
    o_ctx, o_lat = deltanet_bidirectional(qc, kc, vc, ac, bc, ql, kl, vl, al, bl, dn_a_log, dn_dt_bias)
    dn_lat = dn_output(o_lat, dz_l, g_dn_out)

    out_lat = merge_groups(att_lat, lru_lat, dn_lat, g_group, w_out)
    if not need_ctx:
        return out_lat, None
    q_ctx = rmsnorm(aq_c.reshape(bsz, m, ATT_HEADS, HEAD_DIM), g_qk[0])
    att_ctx = attend(q_ctx.reshape(bsz, m, ATT_KV_HEADS, ATT_GROUP, HEAD_DIM), k_ctx, v_ctx).reshape(bsz, m, ATT_WIDTH)
    lru_ctx = (jax.nn.gelu(lg_c.astype(jnp.float32)) * y_ctx).astype(h_ctx.dtype)
    dn_ctx = dn_output(o_ctx, dz_c, g_dn_out)
    out_ctx = merge_groups(att_ctx, lru_ctx, dn_ctx, g_group, w_out)
    return out_lat, out_ctx


def swiglu(h, w_ffn_in, w_ffn_out):
    gate, up = jnp.split(h @ w_ffn_in, 2, axis=-1)
    return (jax.nn.silu(gate) * up) @ w_ffn_out


def setup_inputs(seed: int = 0) -> dict:
    key = jax.random.key(seed)
    ks = iter(jax.random.split(key, 40))
    f32 = jnp.float32

    def nrm(shape, scale):
        return jax.random.normal(next(ks), shape, f32) * scale

    def gain(shape):
        return 1.0 + 0.02 * jax.random.normal(next(ks), shape, f32)

    a0 = jax.random.uniform(next(ks), (DEPTH, N_DIR, LRU_WIDTH), f32, 0.9, 0.999)
    p = a0 ** (1.0 / LRU_C)
    lru_lambda = jnp.log(p) - jnp.log1p(-p)
    dn_a_log = jnp.log(jax.random.uniform(next(ks), (DEPTH, N_DIR, DN_HEADS), f32, 1.0, 16.0))
    dt = jnp.exp(jax.random.uniform(next(ks), (DEPTH, N_DIR, DN_HEADS), f32, np.log(1e-3), np.log(1e-1)))
    dn_dt_bias = dt + jnp.log(-jnp.expm1(-dt))
    return {
        'x': nrm((BATCH, SEQ, D_MODEL), 1.0),
        'c': nrm((BATCH, D_MODEL), 1.0),
        'ctx': nrm((BATCH, CTX_LEN, D_MODEL), 1.0),
        'c_ctx': nrm((D_MODEL,), 1.0),
        'w_ada': nrm((DEPTH, D_MODEL, 6 * D_MODEL), 0.5 * D_MODEL ** -0.5),
        'b_ada': nrm((DEPTH, 6 * D_MODEL), 0.02),
        'g_norm': gain((DEPTH, 4, D_MODEL)),
        'w_in': nrm((DEPTH, D_MODEL, IN_COLS), D_MODEL ** -0.5),
        'g_qk': gain((DEPTH, 2, HEAD_DIM)),
        'lru_conv_w': nrm((DEPTH, LRU_CONV, LRU_WIDTH), LRU_CONV ** -0.5),
        'lru_conv_b': nrm((DEPTH, LRU_WIDTH), 0.02),
        'lru_w_r': nrm((DEPTH, N_DIR, LRU_BLOCKS, LRU_BLOCK_DIM, LRU_BLOCK_DIM), LRU_BLOCK_DIM ** -0.5),
        'lru_b_r': nrm((DEPTH, N_DIR, LRU_WIDTH), 0.02),
        'lru_w_i': nrm((DEPTH, N_DIR, LRU_BLOCKS, LRU_BLOCK_DIM, LRU_BLOCK_DIM), LRU_BLOCK_DIM ** -0.5),
        'lru_b_i': nrm((DEPTH, N_DIR, LRU_WIDTH), 0.02),
        'lru_lambda': lru_lambda,
        'dn_conv_w': nrm((DEPTH, DN_CONV, 3 * DN_WIDTH), DN_CONV ** -0.5),
        'dn_a_log': dn_a_log,
        'dn_dt_bias': dn_dt_bias,
        'g_dn_out': gain((DEPTH, DN_HEAD_DIM)),
        'g_group': gain((DEPTH, ATT_WIDTH + LRU_WIDTH)),
        'w_out': nrm((DEPTH, MIX_WIDTH, D_MODEL), MIX_WIDTH ** -0.5),
        'w_ffn_in': nrm((DEPTH, D_MODEL, 2 * FFN_HIDDEN), D_MODEL ** -0.5),
        'w_ffn_out': nrm((DEPTH, FFN_HIDDEN, D_MODEL), FFN_HIDDEN ** -0.5),
    }


def reference(x, c, ctx, c_ctx, w_ada, b_ada, g_norm, w_in, g_qk, lru_conv_w, lru_conv_b, lru_w_r, lru_b_r,
              lru_w_i, lru_b_i, lru_lambda, dn_conv_w, dn_a_log, dn_dt_bias, g_dn_out, g_group, w_out,
              w_ffn_in, w_ffn_out):
    rows = x.shape[1] // GRID_W
    cos, sin = axial_rope(rows)
    for l in range(DEPTH):
        need_ctx = l < DEPTH - 1
        mod_lat = (jax.nn.silu(c) @ w_ada[l] + b_ada[l])[:, None, :]
        mod_ctx = (jax.nn.silu(c_ctx) @ w_ada[l] + b_ada[l])[None, None, :]
        sh_m, sc_m, gt_m, sh_f, sc_f, gt_f = jnp.split(mod_lat, 6, axis=-1)
        csh_m, csc_m, cgt_m, csh_f, csc_f, cgt_f = jnp.split(mod_ctx, 6, axis=-1)

        h_lat = rmsnorm(x, g_norm[l, 0]) * (1 + sc_m) + sh_m
        h_ctx = rmsnorm(ctx, g_norm[l, 0]) * (1 + csc_m) + csh_m
        mix_lat, mix_ctx = mixer(h_lat, h_ctx, cos, sin, w_in[l], g_qk[l], lru_conv_w[l], lru_conv_b[l],
                                 lru_w_r[l], lru_b_r[l], lru_w_i[l], lru_b_i[l], lru_lambda[l], dn_conv_w[l],
                                 dn_a_log[l], dn_dt_bias[l], g_dn_out[l], g_group[l], w_out[l], need_ctx)
        x = x + gt_m * rmsnorm(mix_lat, g_norm[l, 1])
        h = rmsnorm(x, g_norm[l, 2]) * (1 + sc_f) + sh_f
        x = x + gt_f * rmsnorm(swiglu(h, w_ffn_in[l], w_ffn_out[l]), g_norm[l, 3])

        if need_ctx:
            ctx = ctx + cgt_m * rmsnorm(mix_ctx, g_norm[l, 1])
            hc = rmsnorm(ctx, g_norm[l, 2]) * (1 + csc_f) + csh_f
            ctx = ctx + cgt_f * rmsnorm(swiglu(hc, w_ffn_in[l], w_ffn_out[l]), g_norm[l, 3])
    return x
```

```cpp
#include <hip/hip_runtime.h>
#include <hip/hip_cooperative_groups.h>
#include <cstdio>
namespace cg = cooperative_groups;

#define DI __device__ __forceinline__
typedef unsigned short bfr;
using bf16x8 = __attribute__((ext_vector_type(8))) short;
using f32x16 = __attribute__((ext_vector_type(16))) float;
using u32x4 = __attribute__((ext_vector_type(4))) unsigned;
using u32x2 = __attribute__((ext_vector_type(2))) unsigned;
#define MFMA(a, b, c) __builtin_amdgcn_mfma_f32_32x32x16_bf16((a), (b), (c), 0, 0, 0)

#ifndef REP_GEMM
#define REP_GEMM 1
#endif
#ifndef REP_ATT
#define REP_ATT 1
#endif
#ifndef REP_P0
#define REP_P0 1
#endif
#ifndef REP_T3
#define REP_T3 1
#endif
#ifndef REP_T4
#define REP_T4 1
#endif
#ifndef REP_T6
#define REP_T6 1
#endif
#ifndef REP_NORM
#define REP_NORM 1
#endif
#ifndef REP_SCAN
#define REP_SCAN 1
#endif
constexpr int D = 1024, NB = 2, SEQ = 8192, CTX = 256;
constexpr int MLAT = NB * SEQ, MCTX = NB * CTX, MTOT = MLAT + MCTX;
constexpr int LK = SEQ + CTX;
constexpr int PC = 1024;
constexpr int INP = 2432;
constexpr int FH = 2816;
constexpr int NCH = 132;
constexpr float EPS = 1e-6f;
constexpr int N_ATT_FULL = 960, N_ATT_SPLIT = 64;
constexpr float QSCALE = 0.125f * 1.4426950408889634f;

enum { I_X = 0, I_C, I_CTX, I_CCTX, I_WADA, I_BADA, I_GNORM, I_WIN, I_GQK, I_LCW, I_LCB, I_LWR, I_LBR, I_LWI, I_LBI,
       I_LLAM, I_DCW, I_DALOG, I_DDT, I_GDN, I_GGRP, I_WOUT, I_WF1, I_WF2 };

constexpr size_t SZ_WIN = 2ull * INP * D * 2, SZ_WOUT = 2ull * D * D * 2, SZ_WF1 = 2ull * 2 * FH * D * 2, SZ_WF2 = 2ull * D * FH * 2;
constexpr size_t OFF_WIN = 0, OFF_WOUT = OFF_WIN + SZ_WIN, OFF_WF1 = OFF_WOUT + SZ_WOUT, OFF_WF2 = OFF_WF1 + SZ_WF1;
constexpr size_t OFF_MOD = OFF_WF2 + SZ_WF2;
constexpr size_t OFF_CTXB = OFF_MOD + 2ull * 3 * 6144 * 4;
constexpr size_t OFF_GB = OFF_CTXB + 512ull * 1024 * 4;
constexpr size_t OFF_SSA = OFF_GB + (size_t)MTOT * 16 * 4;
constexpr size_t OFF_SSL = OFF_SSA + (size_t)MTOT * 8 * 4;
constexpr size_t OFF_CAR = OFF_SSL + (size_t)MTOT * 4 * 4;
constexpr size_t OFF_ROPE = OFF_CAR + 2ull * 2 * NCH * 256 * 2 * 4;
constexpr size_t OFF_GT = OFF_ROPE + 8192ull * 32 * 8;
constexpr size_t OFF_WL = OFF_GT + 2112ull * 4 + 256;
constexpr size_t OFF_HIN = OFF_WL + 32ull * 4096 * 2;
constexpr size_t OFF_ML = OFF_HIN + 2ull * 2 * NCH * 256 * 4;
constexpr size_t OFF_CNT = OFF_ML + 256ull * 128 * 8;
constexpr size_t OFF_BAR = OFF_CNT + 256;
constexpr size_t OFF_R = OFF_BAR + 16384;
constexpr size_t U = (size_t)MTOT * 1024 * 2;
constexpr size_t R_H = OFF_R;
constexpr size_t R_XR = OFF_R;
constexpr size_t R_DNQKV = OFF_R + U / 4;
constexpr size_t R_YREST = OFF_R + U / 2;
constexpr size_t R_Q = OFF_R + U;
constexpr size_t R_K = OFF_R + U + U / 2;
constexpr size_t R_VT = R_K + U / 8;
constexpr size_t R_P = OFF_R + 7 * U / 4;
constexpr size_t R_SJ = OFF_R + 7 * U / 4;
constexpr size_t R_YATT = OFF_R + 9 * U / 4;
constexpr size_t R_GZ = OFF_R + 11 * U / 4;
constexpr size_t R_UWA = OFF_R + 13 * U / 4;
constexpr size_t R_MIX = OFF_R + 13 * U / 4;
constexpr size_t R_G = OFF_R + U;
constexpr size_t R_F = OFF_R + 15 * U / 4;
constexpr size_t R_PO = OFF_R + 23 * U / 4;
constexpr size_t WS_NEED = OFF_R + 6 * U;

struct Params { const float* in[24]; float* out; char* ws; };

DI int opaque(int v) { asm volatile("" : "+v"(v)); return v; }
DI float bf2f(bfr u) { return __uint_as_float(((unsigned)u) << 16); }
typedef __attribute__((ext_vector_type(2))) float f32x2_t;
typedef __attribute__((ext_vector_type(2))) __bf16 bf16x2_t;
DI unsigned pack2(float a, float b) { f32x2_t v = {a, b}; bf16x2_t r = __builtin_convertvector(v, bf16x2_t); return __builtin_bit_cast(unsigned, r); }
DI bfr f2bf(float x) { return (bfr)(pack2(x, 0.f) & 0xffffu); }
DI float lo_bf(unsigned u) { return __uint_as_float(u << 16); }
DI float hi_bf(unsigned u) { return __uint_as_float(u & 0xffff0000u); }
DI float wave_sum(float v) {
#pragma unroll
  for (int o = 32; o; o >>= 1) v += __shfl_xor(v, o);
  return v;
}
DI float sigmoidf_(float x) { return __builtin_amdgcn_rcpf(1.f + __expf(-x)); }
DI float siluf_(float x) { return x * __builtin_amdgcn_rcpf(1.f + __expf(-x)); }
DI float softplusf_(float x) { return x > 20.f ? x : log1pf(expf(x)); }
DI float geluf_(float x) { return 0.5f * x * (1.f + tanhf(0.7978845608028654f * (x + 0.044715f * x * x * x))); }
DI float dpp_swap1(float v) { return __int_as_float(__builtin_amdgcn_mov_dpp(__float_as_int(v), 0xB1, 0xF, 0xF, true)); }
DI void store_pair_bf16(bfr* rowa, bfr* rowb, int col, int odd, float a, float b) {
  const float pa = dpp_swap1(a), pb = dpp_swap1(b);
  bfr* ptr = odd ? rowb + col - 1 : rowa + col;
  const unsigned val = odd ? pack2(pb, b) : pack2(a, pa);
  *(unsigned*)ptr = val;
}
DI int crow(int i, int h) { return (i & 3) + 8 * (i >> 2) + 4 * h; }
DI bf16x8 pack_step(const f32x16& x, int s) {
  u32x4 p;
  p[0] = pack2(x[8 * s + 0], x[8 * s + 1]); p[1] = pack2(x[8 * s + 2], x[8 * s + 3]);
  p[2] = pack2(x[8 * s + 4], x[8 * s + 5]); p[3] = pack2(x[8 * s + 6], x[8 * s + 7]);
  return __builtin_bit_cast(bf16x8, p);
}
DI int dn_row(int b, int dir, int j, int c) {
  if (j < 4) { int p = j * 64 + c; int t = dir ? (CTX - 1 - p) : p; return MLAT + b * CTX + t; }
  int p = (j - 4) * 64 + c; int t = dir ? (SEQ - 1 - p) : p; return b * SEQ + t;
}

DI void wconv_tile(const float* __restrict__ W, int K, int N, bfr* __restrict__ Wt, int n0, int srcA, int srcB, int nvalid, int k0, float* tile) {
  const int tid = opaque(threadIdx.x);
  const int c = tid & 63, kr = tid >> 6;
  const int scol = (c < 32) ? srcA + c : srcB + (c - 32);
  float v[16];
#pragma unroll
  for (int q = 0; q < 16; ++q) v[q] = (c < nvalid) ? W[(size_t)(k0 + kr + q * 4) * N + scol] : 0.f;
#pragma unroll
  for (int q = 0; q < 16; ++q) tile[(kr + q * 4) * 65 + c] = v[q];
  __syncthreads();
  const int n = tid >> 2, kc = (tid & 3) * 16;
  u32x4 o0, o1;
#pragma unroll
  for (int j = 0; j < 4; ++j) {
    o0[j] = pack2(tile[(kc + 2 * j) * 65 + n], tile[(kc + 2 * j + 1) * 65 + n]);
    o1[j] = pack2(tile[(kc + 8 + 2 * j) * 65 + n], tile[(kc + 8 + 2 * j + 1) * 65 + n]);
  }
  *(u32x4*)&Wt[(size_t)(n0 + n) * K + k0 + kc] = o0;
  *(u32x4*)&Wt[(size_t)(n0 + n) * K + k0 + kc + 8] = o1;
  __syncthreads();
}

constexpr int WC_IN = 38 * 16, WC_OUT = 16 * 16, WC_F1 = 88 * 16, WC_F2 = 16 * 44;
constexpr int WC_LAYER = WC_IN + WC_OUT + WC_F1 + WC_F2;
constexpr int N_WCONV = 2 * WC_LAYER;
constexpr int N_MOD = 192;
constexpr int N_ROPE = 64;
constexpr int N_WL = 32;

DI void phase0_item(const Params& p, int item, char* smem) {
  float* fs = (float*)smem;
  if (item < N_WCONV) {
    int l = item / WC_LAYER, it = item % WC_LAYER;
    if (it < WC_IN) {
      int nt = it / 16, kt = it % 16;
      int nv = 2320 - nt * 64; nv = nv < 0 ? 0 : (nv > 64 ? 64 : nv);
      wconv_tile(p.in[I_WIN] + (size_t)l * D * 2320, D, 2320, (bfr*)(p.ws + OFF_WIN) + (size_t)l * INP * D, nt * 64, nt * 64, nt * 64 + 32, nv, kt * 64, fs);
    } else if (it < WC_IN + WC_OUT) {
      it -= WC_IN; int nt = it / 16, kt = it % 16;
      wconv_tile(p.in[I_WOUT] + (size_t)l * D * D, D, D, (bfr*)(p.ws + OFF_WOUT) + (size_t)l * D * D, nt * 64, nt * 64, nt * 64 + 32, 64, kt * 64, fs);
    } else if (it < WC_IN + WC_OUT + WC_F1) {
      it -= WC_IN + WC_OUT; int ot = it / 16, kt = it % 16;
      int blk = ot >> 1, wn = ot & 1;
      wconv_tile(p.in[I_WF1] + (size_t)l * D * 2 * FH, D, 2 * FH, (bfr*)(p.ws + OFF_WF1) + (size_t)l * 2 * FH * D, ot * 64, blk * 64 + wn * 32, FH + blk * 64 + wn * 32, 64, kt * 64, fs);
    } else {
      it -= WC_IN + WC_OUT + WC_F1; int nt = it / 44, kt = it % 44;
      wconv_tile(p.in[I_WF2] + (size_t)l * FH * D, FH, D, (bfr*)(p.ws + OFF_WF2) + (size_t)l * D * FH, nt * 64, nt * 64, nt * 64 + 32, 64, kt * 64, fs);
    }
  } else if (item >= N_WCONV + N_MOD + N_ROPE) {
    const int tid = opaque(threadIdx.x);
    const int m = item - (N_WCONV + N_MOD + N_ROPE);
    const int kb = m & 3, gate = (m >> 2) & 1, ld = m >> 3;
    const float* W = p.in[gate ? I_LWI : I_LWR] + ((size_t)ld * 4 + kb) * 4096;
    bfr* dst = (bfr*)(p.ws + OFF_WL) + (size_t)m * 4096;
    const int e = tid >> 2, d0 = (tid & 3) * 16;
    u32x4 o0, o1;
#pragma unroll
    for (int i = 0; i < 4; ++i) {
      o0[i] = pack2(W[(d0 + 2 * i) * 64 + e], W[(d0 + 2 * i + 1) * 64 + e]);
      o1[i] = pack2(W[(d0 + 8 + 2 * i) * 64 + e], W[(d0 + 8 + 2 * i + 1) * 64 + e]);
    }
    *(u32x4*)(dst + e * 64 + d0) = o0; *(u32x4*)(dst + e * 64 + d0 + 8) = o1;
  } else if (item >= N_WCONV + N_MOD) {
    const int tid = opaque(threadIdx.x);
    float2* rope = (float2*)(p.ws + OFF_ROPE);
    const int base = (item - N_WCONV - N_MOD) * 4096;
    for (int q = 0; q < 16; ++q) {
      const int idx = base + q * 256 + tid;
      const int t = idx >> 5, i = idx & 31, f = i & 15;
      const float pos = (i < 16) ? (float)(t >> 6) : (float)(t & 63);
      const float inv = exp2f(-(float)f * (13.287712379549449f / 16.f));
      float sn, cs;
      sincosf(pos * inv, &sn, &cs);
      rope[idx] = make_float2(cs, sn);
    }
  } else {
    int m = item - N_WCONV;
    int l = m / 96, j0 = (m % 96) * 64;
    const int tid = opaque(threadIdx.x);
    for (int i = tid; i < 3072; i += 256) {
      int v = i >> 10, k = i & 1023;
      float cv = (v < 2) ? p.in[I_C][v * 1024 + k] : p.in[I_CCTX][k];
      fs[i] = siluf_(cv);
    }
    __syncthreads();
    const int c4 = (tid & 15) * 4, ks = tid >> 4;
    float4 a0 = make_float4(0.f, 0.f, 0.f, 0.f), a1 = a0, a2 = a0;
    const float* w = p.in[I_WADA] + (size_t)l * D * 6144 + j0 + c4;
#pragma unroll 16
    for (int k = ks * 64; k < ks * 64 + 64; ++k) {
      const float4 wv = *(const float4*)(w + (size_t)k * 6144);
      const float s0 = fs[k], s1 = fs[1024 + k], s2 = fs[2048 + k];
      a0.x += s0 * wv.x; a0.y += s0 * wv.y; a0.z += s0 * wv.z; a0.w += s0 * wv.w;
      a1.x += s1 * wv.x; a1.y += s1 * wv.y; a1.z += s1 * wv.z; a1.w += s1 * wv.w;
      a2.x += s2 * wv.x; a2.y += s2 * wv.y; a2.z += s2 * wv.z; a2.w += s2 * wv.w;
    }
    float* red = fs + 3072;
    *(float4*)&red[(ks * 3 + 0) * 64 + c4] = a0; *(float4*)&red[(ks * 3 + 1) * 64 + c4] = a1; *(float4*)&red[(ks * 3 + 2) * 64 + c4] = a2;
    __syncthreads();
    if (tid < 192) {
      int v = tid >> 6, cc = tid & 63;
      float s = p.in[I_BADA][l * 6144 + j0 + cc];
      for (int q = 0; q < 16; ++q) s += red[(q * 3 + v) * 64 + cc];
      ((float*)(p.ws + OFF_MOD))[(l * 3 + v) * 6144 + j0 + cc] = s;
    }
    __syncthreads();
  }
}

struct RowJob { const float* xin; float* xout; const bfr* br; const float* gbr; const float* gate; const float* gn; const float* scn; const float* shn; bfr* hout; };

DI void resid_norm_rows2(const RowJob (&J)[2], int lane) {
  float4 xv[2][4];
#pragma unroll
  for (int j = 0; j < 2; ++j)
#pragma unroll
    for (int i = 0; i < 4; ++i) xv[j][i] = *(const float4*)(J[j].xin + lane * 4 + i * 256);
  if (J[0].br) {
    float4 bv[2][4]; float ss[2];
#pragma unroll
    for (int j = 0; j < 2; ++j) {
      ss[j] = 0.f;
#pragma unroll
      for (int i = 0; i < 4; ++i) {
        const u32x2 bb = *(const u32x2*)(J[j].br + lane * 4 + i * 256);
        bv[j][i] = make_float4(lo_bf(bb[0]), hi_bf(bb[0]), lo_bf(bb[1]), hi_bf(bb[1]));
        ss[j] += bv[j][i].x * bv[j][i].x + bv[j][i].y * bv[j][i].y + bv[j][i].z * bv[j][i].z + bv[j][i].w * bv[j][i].w;
      }
    }
#pragma unroll
    for (int o = 32; o; o >>= 1) { ss[0] += __shfl_xor(ss[0], o); ss[1] += __shfl_xor(ss[1], o); }
#pragma unroll
    for (int j = 0; j < 2; ++j) {
      const float s = rsqrtf(ss[j] * (1.f / 1024.f) + EPS);
#pragma unroll
      for (int i = 0; i < 4; ++i) {
        const float4 g = *(const float4*)(J[j].gbr + lane * 4 + i * 256), gt = *(const float4*)(J[j].gate + lane * 4 + i * 256);
        xv[j][i].x += gt.x * (bv[j][i].x * s * g.x); xv[j][i].y += gt.y * (bv[j][i].y * s * g.y);
        xv[j][i].z += gt.z * (bv[j][i].z * s * g.z); xv[j][i].w += gt.w * (bv[j][i].w * s * g.w);
        *(float4*)(J[j].xout + lane * 4 + i * 256) = xv[j][i];
      }
    }
  }
  if (J[0].hout) {
    float ss[2];
#pragma unroll
    for (int j = 0; j < 2; ++j) {
      ss[j] = 0.f;
#pragma unroll
      for (int i = 0; i < 4; ++i) ss[j] += xv[j][i].x * xv[j][i].x + xv[j][i].y * xv[j][i].y + xv[j][i].z * xv[j][i].z + xv[j][i].w * xv[j][i].w;
    }
#pragma unroll
    for (int o = 32; o; o >>= 1) { ss[0] += __shfl_xor(ss[0], o); ss[1] += __shfl_xor(ss[1], o); }
#pragma unroll
    for (int j = 0; j < 2; ++j) {
      const float s = rsqrtf(ss[j] * (1.f / 1024.f) + EPS);
#pragma unroll
      for (int i = 0; i < 4; ++i) {
        const float4 g = *(const float4*)(J[j].gn + lane * 4 + i * 256), sc = *(const float4*)(J[j].scn + lane * 4 + i * 256), sh = *(const float4*)(J[j].shn + lane * 4 + i * 256);
        u32x2 o;
        o[0] = pack2(xv[j][i].x * s * g.x * (1.f + sc.x) + sh.x, xv[j][i].y * s * g.y * (1.f + sc.y) + sh.y);
        o[1] = pack2(xv[j][i].z * s * g.z * (1.f + sc.z) + sh.z, xv[j][i].w * s * g.w * (1.f + sc.w) + sh.w);
        *(u32x2*)(J[j].hout + lane * 4 + i * 256) = o;
      }
    }
  }
}

DI RowJob make_rowjob(const Params& p, int l, int mode, int row) {
  RowJob j;
  const bool isctx = row >= MLAT;
  const int b = isctx ? (row - MLAT) / CTX : row / SEQ;
  const int v = isctx ? 2 : b;
  const float* mod = (const float*)(p.ws + OFF_MOD) + (size_t)(l * 3 + v) * 6144;
  const float* gnorm = p.in[I_GNORM] + (size_t)l * 4 * 1024;
  float* ctxb = (float*)(p.ws + OFF_CTXB);
  bfr* H = (bfr*)(p.ws + R_H) + (size_t)row * 1024;
  if (mode == 0) {
    j.xin = isctx ? p.in[I_CTX] + (size_t)(row - MLAT) * 1024 : p.in[I_X] + (size_t)row * 1024;
    j.xout = nullptr; j.br = nullptr; j.gbr = nullptr; j.gate = nullptr;
    j.gn = gnorm; j.scn = mod + 1024; j.shn = mod; j.hout = H;
  } else if (mode == 1) {
    if (isctx) { j.xin = (l == 0) ? p.in[I_CTX] + (size_t)(row - MLAT) * 1024 : ctxb + (size_t)(row - MLAT) * 1024; j.xout = ctxb + (size_t)(row - MLAT) * 1024; }
    else { j.xin = (l == 0) ? p.in[I_X] + (size_t)row * 1024 : p.out + (size_t)row * 1024; j.xout = p.out + (size_t)row * 1024; }
    j.br = (const bfr*)(p.ws + R_MIX) + (size_t)row * 1024;
    j.gbr = gnorm + 1024; j.gate = mod + 2048; j.gn = gnorm + 2048; j.scn = mod + 4096; j.shn = mod + 3072; j.hout = H;
  } else {
    float* xio = isctx ? ctxb + (size_t)(row - MLAT) * 1024 : p.out + (size_t)row * 1024;
    j.xin = xio; j.xout = xio;
    j.br = (const bfr*)(p.ws + R_F) + (size_t)row * 1024;
    j.gbr = gnorm + 3072; j.gate = mod + 5120;
    if (l == 0) {
      const float* mod2 = (const float*)(p.ws + OFF_MOD) + (size_t)(3 + v) * 6144;
      j.gn = p.in[I_GNORM] + (size_t)4 * 1024; j.scn = mod2 + 1024; j.shn = mod2; j.hout = H;
    } else { j.gn = nullptr; j.scn = nullptr; j.shn = nullptr; j.hout = nullptr; }
  }
  return j;
}
DI void rownorm_phase(const Params& p, int l, int mode, int rb) {
  const int tid_ = opaque(threadIdx.x);
  const int lane = tid_ & 63, row = rb * 8 + (tid_ >> 6);
  RowJob J[2];
  J[0] = make_rowjob(p, l, mode, row);
  J[1] = make_rowjob(p, l, mode, row + 4);
  resid_norm_rows2(J, lane);
}

enum { EPI_IN = 0, EPI_F32 = 1, EPI_SWIGLU = 2, EPI_OUTPROJ = 3 };
constexpr int LDT = 72;

template <int EPI, int MTW>
DI void gemm_tile(const Params& p, int l, const bfr* __restrict__ A, int lda, const bfr* __restrict__ A2, const bfr* __restrict__ Wt, int K, int m0, int n0, float* __restrict__ outf, int ldc, char* smem) {
  constexpr int BM = 64 * MTW;
  constexpr int NA = BM / 32;
  bfr* sA = (bfr*)smem; bfr* sB = sA + BM * LDT;
  float* srow = (float*)(smem + (BM + 128) * LDT * 2);
  const int tid = opaque(threadIdx.x), lane = tid & 63, w = tid >> 6, wm = w >> 1, wn = w & 1, r = lane & 31, h = lane >> 5;
  f32x16 acc[MTW][2];
#pragma unroll
  for (int a = 0; a < MTW; ++a)
#pragma unroll
    for (int b = 0; b < 2; ++b)
#pragma unroll
      for (int i = 0; i < 16; ++i) acc[a][b][i] = 0.f;
  const int lrow = tid >> 3, lkc = (tid & 7) * 8;
  const bfr* ga = A + (size_t)(m0 + lrow) * lda + lkc;
  const bfr* ga2 = (EPI == EPI_OUTPROJ) ? A2 + (size_t)(m0 + lrow) * lda + lkc - 512 : nullptr;
  const bfr* gb = Wt + (size_t)(n0 + lrow) * K + lkc;
  constexpr int NST = (MTW <= 2) ? 2 : 1;
  const int nk = K / 64;
  u32x4 ra0[NA], rb0[4], ra1[NA], rb1[4];
#pragma unroll
  for (int i = 0; i < NA; ++i) ra0[i] = *(const u32x4*)(ga + (size_t)i * 32 * lda);
#pragma unroll
  for (int i = 0; i < 4; ++i) rb0[i] = *(const u32x4*)(gb + (size_t)i * 32 * K);
  if (NST == 2) {
#pragma unroll
    for (int i = 0; i < NA; ++i) ra1[i] = *(const u32x4*)(ga + (size_t)i * 32 * lda + 64);
#pragma unroll
    for (int i = 0; i < 4; ++i) rb1[i] = *(const u32x4*)(gb + (size_t)i * 32 * K + 64);
  }
  if (EPI == EPI_OUTPROJ) {
    if (tid < 128) {
      const float* ssa = (const float*)(p.ws + OFF_SSA) + (size_t)(m0 + tid) * 8;
      const float* ssl = (const float*)(p.ws + OFF_SSL) + (size_t)(m0 + tid) * 4;
      float sa = 0.f, sl = 0.f;
      for (int i = 0; i < 8; ++i) sa += ssa[i];
      for (int i = 0; i < 4; ++i) sl += ssl[i];
      sa = rsqrtf(sa * (1.f / 512.f) + EPS); sl = rsqrtf(sl * (1.f / 256.f) + EPS);
      srow[tid] = sa / sl; srow[128 + tid] = sl;
    }
  }
  auto step = [&](const int kt, u32x4 (&ra)[NA], u32x4 (&rb)[4], const int pf) {
    __syncthreads();
#pragma unroll
    for (int i = 0; i < NA; ++i) *(u32x4*)&sA[(lrow + i * 32) * LDT + lkc] = ra[i];
#pragma unroll
    for (int i = 0; i < 4; ++i) *(u32x4*)&sB[(lrow + i * 32) * LDT + lkc] = rb[i];
    __syncthreads();
    if (pf < nk) {
      const int k0 = pf * 64;
      const bfr* gsrc = (EPI == EPI_OUTPROJ && k0 >= 512) ? ga2 : ga;
#pragma unroll
      for (int i = 0; i < NA; ++i) ra[i] = *(const u32x4*)(gsrc + (size_t)i * 32 * lda + k0);
#pragma unroll
      for (int i = 0; i < 4; ++i) rb[i] = *(const u32x4*)(gb + (size_t)i * 32 * K + k0);
    }
    if (EPI == EPI_OUTPROJ) {
      if (kt == 8 || kt == 12) {
        const float* sr = srow + (kt == 8 ? 0 : 128);
#pragma unroll
        for (int mt = 0; mt < MTW; ++mt)
#pragma unroll
          for (int i = 0; i < 16; ++i) {
            float s = sr[wm * (MTW * 32) + mt * 32 + crow(i, h)];
            acc[mt][0][i] *= s; acc[mt][1][i] *= s;
          }
        __builtin_amdgcn_sched_barrier(0);
      }
    }
    bf16x8 fb[2][2], fa[2][MTW];
    fb[0][0] = *(const bf16x8*)&sB[(wn * 64 + r) * LDT + h * 8];
    fb[0][1] = *(const bf16x8*)&sB[(wn * 64 + 32 + r) * LDT + h * 8];
#pragma unroll
    for (int mt = 0; mt < MTW; ++mt) fa[0][mt] = *(const bf16x8*)&sA[(wm * (MTW * 32) + mt * 32 + r) * LDT + h * 8];
#pragma unroll
    for (int ks = 0; ks < 4; ++ks) {
      const int cur = ks & 1, nxt = cur ^ 1;
      if (ks < 3) {
        fb[nxt][0] = *(const bf16x8*)&sB[(wn * 64 + r) * LDT + (ks + 1) * 16 + h * 8];
        fb[nxt][1] = *(const bf16x8*)&sB[(wn * 64 + 32 + r) * LDT + (ks + 1) * 16 + h * 8];
#pragma unroll
        for (int mt = 0; mt < MTW; ++mt) fa[nxt][mt] = *(const bf16x8*)&sA[(wm * (MTW * 32) + mt * 32 + r) * LDT + (ks + 1) * 16 + h * 8];
      }
#pragma unroll
      for (int mt = 0; mt < MTW; ++mt) {
        acc[mt][0] = MFMA(fa[cur][mt], fb[cur][0], acc[mt][0]); acc[mt][1] = MFMA(fa[cur][mt], fb[cur][1], acc[mt][1]);
      }
    }
    if (MTW >= 2) {
      if (pf < nk) __builtin_amdgcn_sched_group_barrier(0x020, NA + 4, 0);
      __builtin_amdgcn_sched_group_barrier(0x100, MTW + 2, 0);
#pragma unroll
      for (int ks = 0; ks < 3; ++ks) {
#pragma unroll
        for (int q = 0; q < MTW + 2; ++q) { __builtin_amdgcn_sched_group_barrier(0x008, 1, 0); __builtin_amdgcn_sched_group_barrier(0x100, 1, 0); }
        if (MTW > 2) __builtin_amdgcn_sched_group_barrier(0x008, (MTW > 2) ? MTW - 2 : 1, 0);
      }
      __builtin_amdgcn_sched_group_barrier(0x008, 2 * MTW, 0);
    }
  };
  if (NST == 1) {
    for (int kt = 0; kt < nk; ++kt) step(kt, ra0, rb0, kt + 1);
  } else {
    for (int kt = 0; kt < nk; kt += 2) { step(kt, ra0, rb0, kt + 2); step(kt + 1, ra1, rb1, kt + 3); }
  }
  if (EPI == EPI_IN) {
    const int nt = n0 >> 7;
    const bool isctx = m0 >= MLAT;
    const int b = isctx ? (m0 - MLAT) / CTX : m0 / SEQ;
    const int t0 = (isctx ? (m0 - MLAT) % CTX : m0 % SEQ) + wm * (MTW * 32);
    if (nt < 5) {
      const bool isq = nt < 4;
      const int head = isq ? nt * 2 + wn : wn;
      const float* gq = p.in[I_GQK] + l * 128 + (isq ? 0 : 64);
      const float g0 = gq[r], g1 = gq[32 + r];
      const float2* rope = (const float2*)(p.ws + OFF_ROPE);
      bfr* dst;
      if (isq) dst = isctx ? (bfr*)(p.ws + R_Q) + (size_t)MLAT * 512 + ((size_t)(b * 8 + head) * CTX + t0) * 64 : (bfr*)(p.ws + R_Q) + ((size_t)(b * 8 + head) * SEQ + t0) * 64;
      else dst = (bfr*)(p.ws + R_K) + ((size_t)(b * 2 + head) * LK + (isctx ? t0 : CTX + t0)) * 64;
#pragma unroll
      for (int mt = 0; mt < MTW; ++mt)
#pragma unroll
        for (int i = 0; i < 16; ++i) {
          const int rr = mt * 32 + crow(i, h);
          float v0 = acc[mt][0][i], v1 = acc[mt][1][i];
          float ss = v0 * v0 + v1 * v1;
          ss += __shfl_xor(ss, 1); ss += __shfl_xor(ss, 2); ss += __shfl_xor(ss, 4); ss += __shfl_xor(ss, 8); ss += __shfl_xor(ss, 16);
          const float rs = rsqrtf(ss * (1.f / 64.f) + EPS);
          float y0 = v0 * rs * g0, y1 = v1 * rs * g1;
          if (!isctx) {
            const float2 cs = rope[(size_t)(t0 + rr) * 32 + r];
            const float o0 = y0 * cs.x - y1 * cs.y, o1 = y1 * cs.x + y0 * cs.y;
            y0 = o0; y1 = o1;
          }
          if (isq) { y0 *= QSCALE; y1 *= QSCALE; }
          dst[(size_t)rr * 64 + r] = f2bf(y0); dst[(size_t)rr * 64 + 32 + r] = f2bf(y1);
        }
    } else if (nt == 5) {
      bfr* vt = (bfr*)(p.ws + R_VT) + (size_t)(b * 2 + wn) * 64 * LK + (isctx ? t0 : CTX + t0);
#pragma unroll
      for (int mt = 0; mt < MTW; ++mt)
#pragma unroll
        for (int nt2 = 0; nt2 < 2; ++nt2)
#pragma unroll
          for (int g = 0; g < 4; ++g) {
            u32x2 o; o[0] = pack2(acc[mt][nt2][4 * g], acc[mt][nt2][4 * g + 1]); o[1] = pack2(acc[mt][nt2][4 * g + 2], acc[mt][nt2][4 * g + 3]);
            *(u32x2*)(vt + (size_t)(nt2 * 32 + r) * LK + mt * 32 + (g >> 1) * 16 + h * 8 + (g & 1) * 4) = o;
          }
    } else if (nt == 18) {
      if (wn == 0 && r < 16) {
        float* GBp = (float*)(p.ws + OFF_GB);
        const float alog = (r < 8) ? expf(p.in[I_DALOG][l * 8 + r]) : 0.f;
        const float dtb = (r < 8) ? p.in[I_DDT][l * 8 + r] : 0.f;
#pragma unroll
        for (int mt = 0; mt < MTW; ++mt)
#pragma unroll
          for (int i = 0; i < 16; ++i) {
            const int row = m0 + wm * (MTW * 32) + mt * 32 + crow(i, h);
            const float v = acc[mt][0][i];
            GBp[(size_t)row * 16 + r] = (r < 8) ? -alog * softplusf_(v + dtb) : sigmoidf_(v);
          }
      }
    } else {
      const bool is_lg = nt < 8, is_dz = nt >= 16;
      bfr* dstb; int ld, c0;
      if (is_lg) { dstb = (bfr*)(p.ws + R_GZ); ld = 512; c0 = n0 - 768; }
      else if (is_dz) { dstb = (bfr*)(p.ws + R_GZ); ld = 512; c0 = 256 + n0 - 2048; }
      else { dstb = (bfr*)(p.ws + R_P); ld = PC; c0 = n0 - 1024; }
#pragma unroll
      for (int mt = 0; mt < MTW; ++mt)
#pragma unroll
        for (int i = 0; i < 16; i += 2) {
          const size_t rowa = (size_t)(m0 + wm * (MTW * 32) + mt * 32 + crow(i, h));
#pragma unroll
          for (int nt2 = 0; nt2 < 2; ++nt2) {
            float va = acc[mt][nt2][i], vb = acc[mt][nt2][i + 1];
            if (is_lg) { va = geluf_(va); vb = geluf_(vb); } else if (is_dz) { va = siluf_(va); vb = siluf_(vb); }
            store_pair_bf16(dstb + rowa * ld, dstb + (rowa + 1) * ld, c0 + wn * 64 + nt2 * 32 + r, r & 1, va, vb);
          }
        }
    }
    return;
  }
  {
    const int odd = r & 1;
    bfr* ob = (bfr*)outf;
#pragma unroll
    for (int mt = 0; mt < MTW; ++mt) {
#pragma unroll
      for (int i = 0; i < 16; i += 2) {
        const size_t rowa = (size_t)(m0 + wm * (MTW * 32) + mt * 32 + crow(i, h)), rowb = rowa + 1;
        if (EPI == EPI_SWIGLU) {
          const int col = (n0 >> 1) + wn * 32 + r;
          const float va = siluf_(acc[mt][0][i]) * acc[mt][1][i], vb = siluf_(acc[mt][0][i + 1]) * acc[mt][1][i + 1];
          store_pair_bf16(ob + rowa * ldc, ob + rowb * ldc, col, odd, va, vb);
        } else {
#pragma unroll
          for (int nt = 0; nt < 2; ++nt) {
            const int col = n0 + wn * 64 + nt * 32 + r;
            store_pair_bf16(ob + rowa * ldc, ob + rowb * ldc, col, odd, acc[mt][nt][i], acc[mt][nt][i + 1]);
          }
        }
      }
    }
  }
}

template <int EPI, int MTW>
DI void gemm_phase(const Params& p, int l, const bfr* A, int lda, const bfr* A2, const bfr* Wt, int K, int ntn, int mrows, float* outf, int ldc, char* smem) {
  const int G = gridDim.x;
  const int bid = ((G & 7) == 0) ? (int)((blockIdx.x & 7) * (G >> 3) + (blockIdx.x >> 3)) : (int)blockIdx.x;
  constexpr int BM = 64 * MTW;
  const int nb = ntn * (mrows / BM);
  int nfull = (nb / G) * G;
  const int rem = nb - nfull;
  int sp = 1;
  if (rem > 0) {
    const int c2 = 2 * ((2 * rem + G - 1) / G), c4 = (MTW >= 4) ? (4 * rem + G - 1) / G : 8;
    int best = 4;
    if (c2 < best) { best = c2; sp = 2; }
    if (c4 < best) { best = c4; sp = 4; }
  }
  if (sp == 1) nfull = nb;
  const int items = nfull + sp * (nb - nfull);
  const int ntm = mrows / BM, gmn = 8 * ntn;
  for (int it = bid; it < items; it += G) {
    const int hh = it - nfull;
    const int t = (it < nfull) ? it : nfull + hh / sp;
    const int grp = t / gmn, first = grp * 8, gsz = (ntm - first < 8) ? ntm - first : 8, wi = t - grp * gmn;
    const int mt_ = first + wi % gsz, nt_ = wi / gsz;
    if (it < nfull) gemm_tile<EPI, MTW>(p, l, A, lda, A2, Wt, K, mt_ * BM, nt_ * 128, outf, ldc, smem);
    else if (sp == 2) gemm_tile<EPI, MTW / 2>(p, l, A, lda, A2, Wt, K, mt_ * BM + (hh & 1) * (BM / 2), nt_ * 128, outf, ldc, smem);
    else if (MTW >= 4) gemm_tile<EPI, (MTW >= 4 ? MTW / 4 : 1)>(p, l, A, lda, A2, Wt, K, mt_ * BM + (hh & 3) * (BM / 4), nt_ * 128, outf, ldc, smem);
  }
}

DI void conv_item(const Params& p, int l, int it) {
  const int tid = opaque(threadIdx.x);
  const int row0 = it * 16;
  const bool isctx = row0 >= MLAT;
  const int t0 = isctx ? (row0 - MLAT) % CTX : row0 % SEQ;
  const int L = isctx ? CTX : SEQ;
  const int ch4 = tid * 4;
  const bfr* P = (const bfr*)(p.ws + R_P);
  if (tid < 64) return;
  u32x2 xv[19];
#pragma unroll
  for (int k = 0; k < 19; ++k) {
    const int tt = t0 - 1 + k;
    if (tt >= 0 && tt < L) xv[k] = *(const u32x2*)(P + (size_t)(row0 - 1 + k) * PC + ch4);
    else { xv[k][0] = 0u; xv[k][1] = 0u; }
  }
  const bool is_lru = tid < 64;
  float4 wv[4], bias;
  if (is_lru) {
#pragma unroll
    for (int tap = 0; tap < 4; ++tap) wv[tap] = *(const float4*)(p.in[I_LCW] + (size_t)l * 1024 + tap * 256 + ch4);
    bias = *(const float4*)(p.in[I_LCB] + l * 256 + ch4);
  } else {
#pragma unroll
    for (int tap = 0; tap < 4; ++tap) wv[tap] = *(const float4*)(p.in[I_DCW] + (size_t)l * 3072 + tap * 768 + (ch4 - 256));
    bias = make_float4(0.f, 0.f, 0.f, 0.f);
  }
  const bool do_l2 = tid < 192;
#pragma unroll
  for (int rr = 0; rr < 16; ++rr) {
    float4 a = bias;
#pragma unroll
    for (int tap = 0; tap < 4; ++tap) {
      const u32x2 x = xv[rr + tap];
      a.x += wv[tap].x * lo_bf(x[0]); a.y += wv[tap].y * hi_bf(x[0]); a.z += wv[tap].z * lo_bf(x[1]); a.w += wv[tap].w * hi_bf(x[1]);
    }
    u32x2 o;
    if (is_lru) {
      o[0] = pack2(a.x, a.y); o[1] = pack2(a.z, a.w);
      *(u32x2*)((bfr*)(p.ws + R_XR) + (size_t)(row0 + rr) * 256 + ch4) = o;
    } else {
      a.x = siluf_(a.x); a.y = siluf_(a.y); a.z = siluf_(a.z); a.w = siluf_(a.w);
      if (do_l2) {
        float ss = a.x * a.x + a.y * a.y + a.z * a.z + a.w * a.w;
        ss += __shfl_xor(ss, 1); ss += __shfl_xor(ss, 2); ss += __shfl_xor(ss, 4); ss += __shfl_xor(ss, 8);
        const float rs = rsqrtf(ss + EPS);
        a.x *= rs; a.y *= rs; a.z *= rs; a.w *= rs;
      }
      o[0] = pack2(a.x, a.y); o[1] = pack2(a.z, a.w);
      *(u32x2*)((bfr*)(p.ws + R_DNQKV) + (size_t)(row0 + rr) * 768 + (ch4 - 256)) = o;
    }
  }
}

DI bf16x8 afrag(const bfr* M, int row, int k0) {
  u32x2 lo = *(const u32x2*)&M[row * LDT + k0];
  u32x2 hi = *(const u32x2*)&M[row * LDT + k0 + 8];
  u32x4 v; v[0] = lo[0]; v[1] = lo[1]; v[2] = hi[0]; v[3] = hi[1];
  return __builtin_bit_cast(bf16x8, v);
}

DI void dn_prep_item(const Params& p, int item, char* smem) {
  float* sx = (float*)smem;
  bfr* sqb = (bfr*)smem;
  bfr* sAt = (bfr*)(smem + 9216);
  bfr* skb = (bfr*)(smem + 32768);
  float* sLT = (float*)(smem + 32768 + 9216);
  float* sgc = (float*)(smem + 32768 + 9216 + 17408);
  float* sbeta = sgc + 64;
  const int tid = opaque(threadIdx.x), lane = tid & 63, w = tid >> 6, r = lane & 31, h = lane >> 5;
  const int j = item % NCH; int rest = item / NCH; const int dir = rest & 1; rest >>= 1; const int hh = rest & 3; const int b = rest >> 2;
  const bfr* DQ = (const bfr*)(p.ws + R_DNQKV);
  const float* GB = (const float*)(p.ws + OFF_GB);
  bfr* UW = (bfr*)(p.ws + R_UWA) + (size_t)item * 5 * 4096;
  {
    const int c = tid >> 2, e0 = (tid & 3) * 16;
    const int row = dn_row(b, dir, j, c);
    const bfr* srcp = DQ + (size_t)row * 768 + hh * 64 + e0;
    *(u32x4*)&sqb[c * LDT + e0] = *(const u32x4*)srcp; *(u32x4*)&sqb[c * LDT + e0 + 8] = *(const u32x4*)(srcp + 8);
    *(u32x4*)&skb[c * LDT + e0] = *(const u32x4*)(srcp + 256); *(u32x4*)&skb[c * LDT + e0 + 8] = *(const u32x4*)(srcp + 256 + 8);
    if (tid < 64) {
      const int rw = dn_row(b, dir, j, tid);
      float g = GB[(size_t)rw * 16 + dir * 4 + hh];
#pragma unroll
      for (int o = 1; o < 64; o <<= 1) { float t = __shfl_up(g, o); if (tid >= o) g += t; }
      sgc[tid] = g;
      sbeta[tid] = GB[(size_t)rw * 16 + 8 + dir * 4 + hh];
    }
  }
  __syncthreads();
  {
    const int ct = w >> 1, kt = w & 1;
    f32x16 KK, QK;
#pragma unroll
    for (int i = 0; i < 16; ++i) { KK[i] = 0.f; QK[i] = 0.f; }
#pragma unroll
    for (int ks = 0; ks < 4; ++ks) {
      const bf16x8 ak = *(const bf16x8*)&skb[(ct * 32 + r) * LDT + ks * 16 + h * 8];
      const bf16x8 aq = *(const bf16x8*)&sqb[(ct * 32 + r) * LDT + ks * 16 + h * 8];
      const bf16x8 bk = *(const bf16x8*)&skb[(kt * 32 + r) * LDT + ks * 16 + h * 8];
      KK = MFMA(ak, bk, KK); QK = MFMA(aq, bk, QK);
    }
    const int k = kt * 32 + r;
    const float gck = sgc[k];
#pragma unroll
    for (int i = 0; i < 16; ++i) {
      const int c = ct * 32 + crow(i, h);
      const float dec = (k <= c) ? __expf(sgc[c] - gck) : 0.f;
      sLT[k * 68 + c] = (k < c) ? sbeta[c] * KK[i] * dec : 0.f;
      sAt[c * LDT + k] = f2bf(QK[i] * 0.125f * dec);
    }
  }
  __syncthreads();
#pragma unroll
  for (int q2 = 0; q2 < 2; ++q2) {
    const int q = tid + q2 * 256;
    const int f = q >> 6, ln = q & 63, rp = ln & 31, hp = ln >> 5;
    const int row = (f >> 2) * 32 + rp, k0 = ((f >> 1) & 1) * 32 + (f & 1) * 16 + 4 * hp;
    const u32x2 alo = *(const u32x2*)&sAt[row * LDT + k0], ahi = *(const u32x2*)&sAt[row * LDT + k0 + 8];
    u32x4 oa; oa[0] = alo[0]; oa[1] = alo[1]; oa[2] = ahi[0]; oa[3] = ahi[1];
    *(u32x4*)(UW + 3 * 4096 + q * 8) = oa;
    const u32x2 qlo = *(const u32x2*)&sqb[row * LDT + k0], qhi = *(const u32x2*)&sqb[row * LDT + k0 + 8];
    const float fq = 0.125f * __expf(sgc[row]);
    u32x4 oq;
    oq[0] = pack2(lo_bf(qlo[0]) * fq, hi_bf(qlo[0]) * fq); oq[1] = pack2(lo_bf(qlo[1]) * fq, hi_bf(qlo[1]) * fq);
    oq[2] = pack2(lo_bf(qhi[0]) * fq, hi_bf(qhi[0]) * fq); oq[3] = pack2(lo_bf(qhi[1]) * fq, hi_bf(qhi[1]) * fq);
    *(u32x4*)(UW + 4 * 4096 + q * 8) = oq;
  }
  __syncthreads();
  {
    const int c = tid >> 2, part = tid & 3;
    float* dst = sx + c * 128 + part * 32;
    if (part < 2) {
      const int row = dn_row(b, dir, j, c);
      const bfr* srcp = DQ + (size_t)row * 768 + 512 + hh * 64 + part * 32;
      const float f = sbeta[c];
#pragma unroll
      for (int q = 0; q < 4; ++q) {
        u32x4 v = *(const u32x4*)(srcp + q * 8);
        *(float4*)(dst + q * 8) = make_float4(lo_bf(v[0]) * f, hi_bf(v[0]) * f, lo_bf(v[1]) * f, hi_bf(v[1]) * f);
        *(float4*)(dst + q * 8 + 4) = make_float4(lo_bf(v[2]) * f, hi_bf(v[2]) * f, lo_bf(v[3]) * f, hi_bf(v[3]) * f);
      }
    } else {
      const bfr* srcp = skb + c * LDT + (part - 2) * 32;
      const float f = sbeta[c] * __expf(sgc[c]);
#pragma unroll
      for (int q = 0; q < 4; ++q) {
        u32x4 v = *(const u32x4*)(srcp + q * 8);
        *(float4*)(dst + q * 8) = make_float4(lo_bf(v[0]) * f, hi_bf(v[0]) * f, lo_bf(v[1]) * f, hi_bf(v[1]) * f);
        *(float4*)(dst + q * 8 + 4) = make_float4(lo_bf(v[2]) * f, hi_bf(v[2]) * f, lo_bf(v[3]) * f, hi_bf(v[3]) * f);
      }
    }
  }
  __syncthreads();
  if (tid < 128) {
    const int col = tid;
    for (int rb = 0; rb < 4; ++rb) {
      float acc[16];
#pragma unroll
      for (int i = 0; i < 16; ++i) acc[i] = sx[(rb * 16 + i) * 128 + col];
      for (int k = 0; k < rb * 16; ++k) {
        const float xk = sx[k * 128 + col];
        const float* lp = sLT + k * 68 + rb * 16;
        float4 l0 = *(const float4*)lp, l1 = *(const float4*)(lp + 4), l2 = *(const float4*)(lp + 8), l3 = *(const float4*)(lp + 12);
        acc[0] -= l0.x * xk; acc[1] -= l0.y * xk; acc[2] -= l0.z * xk; acc[3] -= l0.w * xk;
        acc[4] -= l1.x * xk; acc[5] -= l1.y * xk; acc[6] -= l1.z * xk; acc[7] -= l1.w * xk;
        acc[8] -= l2.x * xk; acc[9] -= l2.y * xk; acc[10] -= l2.z * xk; acc[11] -= l2.w * xk;
        acc[12] -= l3.x * xk; acc[13] -= l3.y * xk; acc[14] -= l3.z * xk; acc[15] -= l3.w * xk;
      }
#pragma unroll
      for (int k2 = 0; k2 < 15; ++k2) {
        const float* lp = sLT + (rb * 16 + k2) * 68 + rb * 16;
#pragma unroll
        for (int i = k2 + 1; i < 16; ++i) acc[i] -= lp[i] * acc[k2];
      }
#pragma unroll
      for (int i = 0; i < 16; ++i) sx[(rb * 16 + i) * 128 + col] = acc[i];
    }
  }
  __syncthreads();
  {
    const float gcl = sgc[63];
#pragma unroll
    for (int q2 = 0; q2 < 2; ++q2) {
      const int q = tid + q2 * 256;
      {
        const int f = q >> 6, ln = q & 63, rp = ln & 31, hp = ln >> 5;
        const int row = (f >> 2) * 32 + rp, k0 = ((f >> 1) & 1) * 32 + (f & 1) * 16 + 4 * hp;
        const float4 a = *(const float4*)&sx[row * 128 + 64 + k0], bq = *(const float4*)&sx[row * 128 + 64 + k0 + 8];
        u32x4 ow; ow[0] = pack2(a.x, a.y); ow[1] = pack2(a.z, a.w); ow[2] = pack2(bq.x, bq.y); ow[3] = pack2(bq.z, bq.w);
        *(u32x4*)(UW + 1 * 4096 + q * 8) = ow;
        float kv[8];
#pragma unroll
        for (int jj = 0; jj < 8; ++jj) {
          const int c = k0 + (jj & 3) + 8 * (jj >> 2);
          kv[jj] = bf2f(skb[c * LDT + row]) * __expf(gcl - sgc[c]);
        }
        u32x4 ok; ok[0] = pack2(kv[0], kv[1]); ok[1] = pack2(kv[2], kv[3]); ok[2] = pack2(kv[4], kv[5]); ok[3] = pack2(kv[6], kv[7]);
        *(u32x4*)(UW + 2 * 4096 + q * 8) = ok;
      }
      {
        const int half = q & 1, ln = (q >> 1) & 63, tile = q >> 7, rp = ln & 31, hp = ln >> 5;
        const int ct = tile >> 1, et = tile & 1;
        float uv[8];
#pragma unroll
        for (int ii = 0; ii < 8; ++ii) uv[ii] = sx[(ct * 32 + crow(half * 8 + ii, hp)) * 128 + et * 32 + rp];
        u32x4 ou; ou[0] = pack2(uv[0], uv[1]); ou[1] = pack2(uv[2], uv[3]); ou[2] = pack2(uv[4], uv[5]); ou[3] = pack2(uv[6], uv[7]);
        *(u32x4*)(UW + q * 8) = ou;
      }
    }
    if (tid == 0) ((float*)(p.ws + OFF_GT))[item] = __expf(gcl);
  }
  __syncthreads();
}

template <bool FINAL>
DI void lru_item(const Params& p, int l, int item, char* smem) {
  bfr* xs = (bfr*)smem;
  bfr* sW = xs + 64 * LDT;
  float* segA = (float*)(smem + 5 * 9216);
  float* segH = segA + 1024;
  float* partA = segH + 1024;
  float* partH = partA + 256;
  float* ssp = partH + 256;
  const int tid = opaque(threadIdx.x), lane = tid & 63, w = tid >> 6, r = lane & 31, h = lane >> 5;
  const int tt = w >> 1, et = w & 1, e = et * 32 + r;
  const int kb = item & 3; int rest = item >> 2; const int tb = rest % NCH; const int b = rest / NCH;
  if (FINAL && l == 1 && tb < 4) return;
  const int row0 = (tb < 4) ? MLAT + b * CTX + tb * 64 : b * SEQ + (tb - 4) * 64;
  const int ch = kb * 64 + e;
  {
    const int n = tid >> 2, c0 = (tid & 3) * 16;
    bfr* xrp = (bfr*)(p.ws + R_XR) + (size_t)(row0 + n) * 256 + kb * 64 + c0;
    if (FINAL) {
      *(u32x4*)&xs[n * LDT + c0] = *(const u32x4*)xrp; *(u32x4*)&xs[n * LDT + c0 + 8] = *(const u32x4*)(xrp + 8);
    } else {
      const int t = ((tb < 4) ? tb * 64 : (tb - 4) * 64) + n, L = (tb < 4) ? CTX : SEQ;
      const bfr* P = (const bfr*)(p.ws + R_P);
      const float* cw = p.in[I_LCW] + (size_t)l * 1024 + kb * 64 + c0;
      float a[16];
      {
        const float* cb = p.in[I_LCB] + l * 256 + kb * 64 + c0;
#pragma unroll
        for (int q = 0; q < 4; ++q) { const float4 bv = *(const float4*)(cb + q * 4); a[q * 4] = bv.x; a[q * 4 + 1] = bv.y; a[q * 4 + 2] = bv.z; a[q * 4 + 3] = bv.w; }
      }
#pragma unroll
      for (int tap = 0; tap < 4; ++tap) {
        const int tt = t - 1 + tap;
        if (tt >= 0 && tt < L) {
          const bfr* xp = P + (size_t)(row0 + n - 1 + tap) * PC + kb * 64 + c0;
          const u32x4 x0 = *(const u32x4*)xp, x1 = *(const u32x4*)(xp + 8);
#pragma unroll
          for (int q = 0; q < 4; ++q) {
            const float4 wv = *(const float4*)(cw + tap * 256 + q * 4);
            const unsigned ua = (q < 2) ? x0[q * 2] : x1[(q - 2) * 2], ub = (q < 2) ? x0[q * 2 + 1] : x1[(q - 2) * 2 + 1];
            a[q * 4] += wv.x * lo_bf(ua); a[q * 4 + 1] += wv.y * hi_bf(ua); a[q * 4 + 2] += wv.z * lo_bf(ub); a[q * 4 + 3] += wv.w * hi_bf(ub);
          }
        }
      }
      u32x4 o0, o1;
#pragma unroll
      for (int q = 0; q < 4; ++q) { o0[q] = pack2(a[2 * q], a[2 * q + 1]); o1[q] = pack2(a[8 + 2 * q], a[8 + 2 * q + 1]); }
      *(u32x4*)&xs[n * LDT + c0] = o0; *(u32x4*)&xs[n * LDT + c0 + 8] = o1;
      *(u32x4*)xrp = o0; *(u32x4*)(xrp + 8) = o1;
    }
#pragma unroll
    for (int m = 0; m < 4; ++m) {
      const bfr* wsrc = (const bfr*)(p.ws + OFF_WL) + ((size_t)((l * 2 + (m >> 1)) * 2 + (m & 1)) * 4 + kb) * 4096 + n * 64 + c0;
      *(u32x4*)&sW[(m * 64 + n) * LDT + c0] = *(const u32x4*)wsrc; *(u32x4*)&sW[(m * 64 + n) * LDT + c0 + 8] = *(const u32x4*)(wsrc + 8);
    }
  }
  __syncthreads();
  float y[16];
#pragma unroll
  for (int i = 0; i < 16; ++i) y[i] = 0.f;
  float* carry = (float*)(p.ws + OFF_CAR);
#pragma unroll
  for (int dir = 0; dir < 2; ++dir) {
    f32x16 zr, zi;
#pragma unroll
    for (int i = 0; i < 16; ++i) { zr[i] = 0.f; zi[i] = 0.f; }
#pragma unroll
    for (int ks = 0; ks < 4; ++ks) {
      const bf16x8 af = *(const bf16x8*)&xs[(tt * 32 + r) * LDT + ks * 16 + h * 8];
      const bf16x8 wr = *(const bf16x8*)&sW[((dir * 2 + 0) * 64 + e) * LDT + ks * 16 + h * 8];
      const bf16x8 wi = *(const bf16x8*)&sW[((dir * 2 + 1) * 64 + e) * LDT + ks * 16 + h * 8];
      zr = MFMA(af, wr, zr); zi = MFMA(af, wi, zi);
    }
    const float br = p.in[I_LBR][(l * 2 + dir) * 256 + ch], bi = p.in[I_LBI][(l * 2 + dir) * 256 + ch];
    const float sp = softplusf_(-p.in[I_LLAM][(l * 2 + dir) * 256 + ch]);
    float a[16], u[16];
#pragma unroll
    for (int i = 0; i < 16; ++i) {
      const float rg = sigmoidf_(zr[i] + br), ig = sigmoidf_(zi[i] + bi);
      const float la = -8.f * rg * sp;
      a[i] = __expf(la);
      const float mult = __builtin_amdgcn_sqrtf(fmaxf(1.f - a[i] * a[i], 0.f));
      u[i] = mult * ig * bf2f(xs[(tt * 32 + crow(i, h)) * LDT + e]);
    }
#pragma unroll
    for (int g = 0; g < 4; ++g) {
      float A = 1.f, H = 0.f;
      if (dir == 0) {
#pragma unroll
        for (int i = 4 * g; i < 4 * g + 4; ++i) { H = a[i] * H + u[i]; A *= a[i]; }
      } else {
#pragma unroll
        for (int i = 4 * g + 3; i >= 4 * g; --i) { H = a[i] * H + u[i]; A *= a[i]; }
      }
      segA[(tt * 8 + 2 * g + h) * 64 + e] = A; segH[(tt * 8 + 2 * g + h) * 64 + e] = H;
    }
    const int j = (tb < 4) ? (dir ? 3 - tb : tb) : (dir ? 4 + 127 - (tb - 4) : tb);
    float hin = 0.f;
    if (FINAL) hin = ((const float*)(p.ws + OFF_HIN))[((size_t)(b * 2 + dir) * NCH + j) * 256 + ch];
    __syncthreads();
    if (!FINAL) {
      if (tid < 64) {
        float At = 1.f, Ht = 0.f;
#pragma unroll
        for (int s = 0; s < 16; ++s) {
          const int sg = dir ? 15 - s : s;
          Ht = segA[sg * 64 + tid] * Ht + segH[sg * 64 + tid]; At *= segA[sg * 64 + tid];
        }
        *(float2*)(carry + ((size_t)(b * 2 + dir) * NCH + j) * 512 + (kb * 64 + tid) * 2) = make_float2(At, Ht);
      }
    } else {
      float st = hin;
      float start[4] = {0.f, 0.f, 0.f, 0.f};
#pragma unroll
      for (int s = 0; s < 16; ++s) {
        const int sg = dir ? 15 - s : s;
        const bool mine = ((sg >> 3) == tt) && ((sg & 1) == h);
        start[(sg >> 1) & 3] = mine ? st : start[(sg >> 1) & 3];
        st = segA[sg * 64 + e] * st + segH[sg * 64 + e];
      }
#pragma unroll
      for (int g = 0; g < 4; ++g) {
        float hs = start[g];
        if (dir == 0) {
#pragma unroll
          for (int i = 4 * g; i < 4 * g + 4; ++i) { hs = a[i] * hs + u[i]; y[i] += hs; }
        } else {
#pragma unroll
          for (int i = 4 * g + 3; i >= 4 * g; --i) { hs = a[i] * hs + u[i]; y[i] += hs; }
        }
      }
    }
    __syncthreads();
  }
  if (FINAL) {
    const bfr* GZ = (const bfr*)(p.ws + R_GZ);
    bfr* Y = (bfr*)(p.ws + R_YREST);
    const float gg = p.in[I_GGRP][l * 768 + 512 + ch];
#pragma unroll
    for (int i = 0; i < 16; ++i) {
      const int n = tt * 32 + crow(i, h);
      const size_t row = (size_t)(row0 + n);
      const float o = bf2f(GZ[row * 512 + ch]) * y[i];
      float ss = o * o;
      ss += __shfl_xor(ss, 1); ss += __shfl_xor(ss, 2); ss += __shfl_xor(ss, 4); ss += __shfl_xor(ss, 8); ss += __shfl_xor(ss, 16);
      if (r == 0) ssp[et * 64 + n] = ss;
      Y[row * 512 + ch] = f2bf(o * gg);
    }
    __syncthreads();
    if (tid < 64) ((float*)(p.ws + OFF_SSL))[(size_t)(row0 + tid) * 4 + kb] = ssp[tid] + ssp[64 + tid];
  }
  __syncthreads();
}

DI void lru_prefix_item(const Params& p, int item) {
  const int tid = opaque(threadIdx.x);
  const float* cb = (const float*)(p.ws + OFF_CAR) + (size_t)item * NCH * 512 + tid * 2;
  float* hin = (float*)(p.ws + OFF_HIN) + (size_t)item * NCH * 256 + tid;
  float st = 0.f;
  for (int j0 = 0; j0 < NCH; j0 += 33) {
    float2 cv[33];
#pragma unroll
    for (int q = 0; q < 33; ++q) cv[q] = *(const float2*)(cb + (size_t)(j0 + q) * 512);
#pragma unroll
    for (int q = 0; q < 33; ++q) { hin[(size_t)(j0 + q) * 256] = st; st = cv[q].x * st + cv[q].y; }
  }
}

DI void unpack_u(const u32x4& a, const u32x4& b, float* o) {
#pragma unroll
  for (int i = 0; i < 4; ++i) { o[2 * i] = lo_bf(a[i]); o[2 * i + 1] = hi_bf(a[i]); o[8 + 2 * i] = lo_bf(b[i]); o[8 + 2 * i + 1] = hi_bf(b[i]); }
}

DI void dn_chain_item(const Params& p, int item) {
  const int tid = opaque(threadIdx.x), lane = tid & 63, w = tid >> 6;
  if (w < 2) {
    const int et = w;
    const bfr* UW = (const bfr*)(p.ws + R_UWA) + (size_t)item * NCH * 5 * 4096;
    const float* GT = (const float*)(p.ws + OFF_GT) + (size_t)item * NCH;
    bfr* SJ = (bfr*)(p.ws + R_SJ) + ((size_t)item * NCH * 2 + et) * 2048;
    f32x16 S[2];
#pragma unroll
    for (int i = 0; i < 16; ++i) { S[0][i] = 0.f; S[1][i] = 0.f; }
    bf16x8 nw[8], nk[8]; u32x4 nu[4]; float ngt;
    {
      const bfr* m = UW;
#pragma unroll
      for (int f = 0; f < 8; ++f) { nw[f] = *(const bf16x8*)(m + 4096 + (f * 64 + lane) * 8); nk[f] = *(const bf16x8*)(m + 8192 + (f * 64 + lane) * 8); }
#pragma unroll
      for (int ct = 0; ct < 2; ++ct) { const bfr* up = m + ((ct * 2 + et) * 64 + lane) * 16; nu[ct * 2] = *(const u32x4*)up; nu[ct * 2 + 1] = *(const u32x4*)(up + 8); }
      ngt = GT[0];
    }
    for (int j = 0; j < NCH; ++j) {
      bf16x8 cw[8], ck[8]; u32x4 cu[4];
#pragma unroll
      for (int f = 0; f < 8; ++f) { cw[f] = nw[f]; ck[f] = nk[f]; }
#pragma unroll
      for (int f = 0; f < 4; ++f) cu[f] = nu[f];
      const float gt = ngt;
      if (j + 1 < NCH) {
        const bfr* m = UW + (size_t)(j + 1) * 5 * 4096;
#pragma unroll
        for (int f = 0; f < 8; ++f) { nw[f] = *(const bf16x8*)(m + 4096 + (f * 64 + lane) * 8); nk[f] = *(const bf16x8*)(m + 8192 + (f * 64 + lane) * 8); }
#pragma unroll
        for (int ct = 0; ct < 2; ++ct) { const bfr* up = m + ((ct * 2 + et) * 64 + lane) * 16; nu[ct * 2] = *(const u32x4*)up; nu[ct * 2 + 1] = *(const u32x4*)(up + 8); }
        ngt = GT[j + 1];
      }
      bf16x8 Sb[2][2];
#pragma unroll
      for (int dt = 0; dt < 2; ++dt)
#pragma unroll
        for (int s = 0; s < 2; ++s) {
          Sb[dt][s] = pack_step(S[dt], s);
          *(bf16x8*)(SJ + (size_t)j * 4096 + ((dt * 2 + s) * 64 + lane) * 8) = Sb[dt][s];
        }
      f32x16 WS[2];
#pragma unroll
      for (int ct = 0; ct < 2; ++ct) {
#pragma unroll
        for (int i = 0; i < 16; ++i) WS[ct][i] = 0.f;
#pragma unroll
        for (int dt = 0; dt < 2; ++dt)
#pragma unroll
          for (int s = 0; s < 2; ++s) WS[ct] = MFMA(cw[(ct * 2 + dt) * 2 + s], Sb[dt][s], WS[ct]);
      }
      bf16x8 Vb[2][2];
#pragma unroll
      for (int ct = 0; ct < 2; ++ct) {
        float uf[16];
        unpack_u(cu[ct * 2], cu[ct * 2 + 1], uf);
        f32x16 vn;
#pragma unroll
        for (int i = 0; i < 16; ++i) vn[i] = uf[i] - WS[ct][i];
        Vb[ct][0] = pack_step(vn, 0); Vb[ct][1] = pack_step(vn, 1);
      }
#pragma unroll
      for (int i = 0; i < 16; ++i) { S[0][i] *= gt; S[1][i] *= gt; }
#pragma unroll
      for (int dt = 0; dt < 2; ++dt)
#pragma unroll
        for (int ct = 0; ct < 2; ++ct)
#pragma unroll
          for (int s = 0; s < 2; ++s) S[dt] = MFMA(ck[(dt * 2 + ct) * 2 + s], Vb[ct][s], S[dt]);
    }
  }
  __syncthreads();
}

DI void dn_out_item(const Params& p, int l, int item, char* smem) {
  float* so = (float*)smem;
  const int tid = opaque(threadIdx.x), lane = tid & 63, w = tid >> 6, r = lane & 31, h = lane >> 5;
  const int tb = item % NCH; const int bh = item / NCH; const int hh = bh & 3, b = bh >> 2;
  if (l == 1 && tb < 4) return;
  const int dir = w >> 1, et = w & 1;
  const int j = dir ? (tb < 4 ? 3 - tb : 4 + 127 - (tb - 4)) : tb;
  const size_t idx = (size_t)((b * 4 + hh) * 2 + dir) * NCH + j;
  const bfr* m = (const bfr*)(p.ws + R_UWA) + idx * 5 * 4096;
  const bfr* SJ = (const bfr*)(p.ws + R_SJ) + (idx * 2 + et) * 2048;
  bf16x8 Sb[2][2];
#pragma unroll
  for (int dt = 0; dt < 2; ++dt)
#pragma unroll
    for (int s = 0; s < 2; ++s) Sb[dt][s] = *(const bf16x8*)(SJ + ((dt * 2 + s) * 64 + lane) * 8);
  f32x16 WS[2], O[2];
#pragma unroll
  for (int ct = 0; ct < 2; ++ct) {
#pragma unroll
    for (int i = 0; i < 16; ++i) { WS[ct][i] = 0.f; O[ct][i] = 0.f; }
#pragma unroll
    for (int dt = 0; dt < 2; ++dt)
#pragma unroll
      for (int s = 0; s < 2; ++s) {
        const int f = (ct * 2 + dt) * 2 + s;
        const bf16x8 wf = *(const bf16x8*)(m + 4096 + (f * 64 + lane) * 8);
        const bf16x8 qf = *(const bf16x8*)(m + 4 * 4096 + (f * 64 + lane) * 8);
        WS[ct] = MFMA(wf, Sb[dt][s], WS[ct]);
        O[ct] = MFMA(qf, Sb[dt][s], O[ct]);
      }
  }
  bf16x8 Vb[2][2];
#pragma unroll
  for (int ct = 0; ct < 2; ++ct) {
    const bfr* up = m + ((ct * 2 + et) * 64 + lane) * 16;
    const u32x4 u0 = *(const u32x4*)up, u1 = *(const u32x4*)(up + 8);
    float uf[16];
    unpack_u(u0, u1, uf);
    f32x16 vn;
#pragma unroll
    for (int i = 0; i < 16; ++i) vn[i] = uf[i] - WS[ct][i];
    Vb[ct][0] = pack_step(vn, 0); Vb[ct][1] = pack_step(vn, 1);
  }
#pragma unroll
  for (int ct = 0; ct < 2; ++ct)
#pragma unroll
    for (int c2 = 0; c2 < 2; ++c2)
#pragma unroll
      for (int s = 0; s < 2; ++s) {
        const int f = (ct * 2 + c2) * 2 + s;
        const bf16x8 af = *(const bf16x8*)(m + 3 * 4096 + (f * 64 + lane) * 8);
        O[ct] = MFMA(af, Vb[c2][s], O[ct]);
      }
  if (dir == 0) {
#pragma unroll
    for (int ct = 0; ct < 2; ++ct)
#pragma unroll
      for (int i = 0; i < 16; ++i) so[(ct * 32 + crow(i, h)) * 65 + et * 32 + r] = O[ct][i];
  }
  __syncthreads();
  if (dir == 1) {
#pragma unroll
    for (int ct = 0; ct < 2; ++ct)
#pragma unroll
      for (int i = 0; i < 16; ++i) so[(63 - (ct * 32 + crow(i, h))) * 65 + et * 32 + r] += O[ct][i];
  }
  __syncthreads();
  {
    const int n = tid >> 2, e0 = (tid & 3) * 16;
    const int row = ((tb < 4) ? MLAT + b * CTX + tb * 64 : b * SEQ + (tb - 4) * 64) + n;
    float v[16]; float ss = 0.f;
#pragma unroll
    for (int i = 0; i < 16; ++i) { v[i] = so[n * 65 + e0 + i]; ss += v[i] * v[i]; }
    ss += __shfl_xor(ss, 1); ss += __shfl_xor(ss, 2);
    const float rs = rsqrtf(ss * (1.f / 64.f) + EPS);
    const bfr* gz = (const bfr*)(p.ws + R_GZ) + (size_t)row * 512 + 256 + hh * 64 + e0;
    const u32x4 z0 = *(const u32x4*)gz, z1 = *(const u32x4*)(gz + 8);
    float zf[16]; unpack_u(z0, z1, zf);
    const float* gd = p.in[I_GDN] + l * 64 + e0;
    u32x4 o0, o1;
#pragma unroll
    for (int i = 0; i < 4; ++i) {
      o0[i] = pack2(v[2 * i] * rs * gd[2 * i] * zf[2 * i], v[2 * i + 1] * rs * gd[2 * i + 1] * zf[2 * i + 1]);
      o1[i] = pack2(v[8 + 2 * i] * rs * gd[8 + 2 * i] * zf[8 + 2 * i], v[8 + 2 * i + 1] * rs * gd[8 + 2 * i + 1] * zf[8 + 2 * i + 1]);
    }
    bfr* y = (bfr*)(p.ws + R_YREST) + (size_t)row * 512 + 256 + hh * 64 + e0;
    *(u32x4*)y = o0; *(u32x4*)(y + 8) = o1;
  }
  __syncthreads();
}

DI void attn_item(const Params& p, int l, const bfr* __restrict__ Qp, const bfr* __restrict__ Kp0, const bfr* __restrict__ Vtp0, int kbeg, int nkeys, int out_row0, int head, int part, char* smem) {
  const bfr* Kp = Kp0 + (size_t)kbeg * 64;
  const bfr* Vtp = Vtp0 + kbeg;
  constexpr int LDV = 136;
  bfr* sK = (bfr*)smem;
  bfr* sV = sK + 128 * LDT;
  const int tid = opaque(threadIdx.x), lane = tid & 63, w = tid >> 6, r = lane & 31, h = lane >> 5;
  bf16x8 qf[4];
#pragma unroll
  for (int ks = 0; ks < 4; ++ks) qf[ks] = *(const bf16x8*)(Qp + (size_t)(w * 32 + r) * 64 + ks * 16 + h * 8);
  f32x16 O[2];
#pragma unroll
  for (int i = 0; i < 16; ++i) { O[0][i] = 0.f; O[1][i] = 0.f; }
  float m = -1e30f, lsum = 0.f;
  const int kr = tid >> 1, kc = (tid & 1) * 32;
  const int vr = tid >> 2, vc = (tid & 3) * 32;
  const bfr* gk = Kp + (size_t)kr * 64 + kc;
  const bfr* gv = Vtp + (size_t)vr * LK + vc;
  u32x4 rk[4], rv[4];
#pragma unroll
  for (int i = 0; i < 4; ++i) { rk[i] = *(const u32x4*)(gk + i * 8); rv[i] = *(const u32x4*)(gv + i * 8); }
  for (int kb = 0; kb < nkeys; kb += 128) {
    __syncthreads();
#pragma unroll
    for (int i = 0; i < 4; ++i) { *(u32x4*)&sK[kr * LDT + kc + i * 8] = rk[i]; *(u32x4*)&sV[vr * LDV + vc + i * 8] = rv[i]; }
    __syncthreads();
    if (kb + 128 < nkeys) {
      const bfr* gk2 = gk + (size_t)(kb + 128) * 64; const bfr* gv2 = gv + (kb + 128);
#pragma unroll
      for (int i = 0; i < 4; ++i) { rk[i] = *(const u32x4*)(gk2 + i * 8); rv[i] = *(const u32x4*)(gv2 + i * 8); }
    }
    f32x16 st[4];
#pragma unroll
    for (int t2 = 0; t2 < 4; ++t2) {
#pragma unroll
      for (int i = 0; i < 16; ++i) st[t2][i] = 0.f;
#pragma unroll
      for (int ks = 0; ks < 4; ++ks) {
        bf16x8 kf = *(const bf16x8*)&sK[(t2 * 32 + r) * LDT + ks * 16 + h * 8];
        st[t2] = MFMA(kf, qf[ks], st[t2]);
      }
    }
    float mx = st[0][0];
#pragma unroll
    for (int t2 = 0; t2 < 4; ++t2)
#pragma unroll
      for (int i = 0; i < 16; ++i) mx = fmaxf(mx, st[t2][i]);
    mx = fmaxf(mx, __shfl_xor(mx, 32));
    const float mnew = fmaxf(m, mx);
    const float alpha = __builtin_amdgcn_exp2f(m - mnew);
    m = mnew;
    float ps = 0.f;
#pragma unroll
    for (int t2 = 0; t2 < 4; ++t2)
#pragma unroll
      for (int i = 0; i < 16; ++i) { float pv = __builtin_amdgcn_exp2f(st[t2][i] - mnew); st[t2][i] = pv; ps += pv; }
    lsum = lsum * alpha + ps;
#pragma unroll
    for (int i = 0; i < 16; ++i) { O[0][i] *= alpha; O[1][i] *= alpha; }
#pragma unroll
    for (int t2 = 0; t2 < 4; ++t2)
#pragma unroll
      for (int s = 0; s < 2; ++s) {
        bf16x8 pb = pack_step(st[t2], s);
#pragma unroll
        for (int dt = 0; dt < 2; ++dt) {
          bf16x8 vf = *(const bf16x8*)&sV[(dt * 32 + r) * LDV + t2 * 32 + s * 16 + h * 8];
          O[dt] = MFMA(vf, pb, O[dt]);
        }
      }
  }
  lsum += __shfl_xor(lsum, 32);
  if (part >= 0) {
    float* po = (float*)(p.ws + R_PO) + ((size_t)part * 128 + w * 32 + r) * 64;
#pragma unroll
    for (int dt = 0; dt < 2; ++dt)
#pragma unroll
      for (int g = 0; g < 4; ++g)
        *(float4*)(po + dt * 32 + 8 * g + 4 * h) = make_float4(O[dt][4 * g], O[dt][4 * g + 1], O[dt][4 * g + 2], O[dt][4 * g + 3]);
    if (h == 0) ((float2*)(p.ws + OFF_ML))[(size_t)part * 128 + w * 32 + r] = make_float2(m, lsum);
    __syncthreads();
    return;
  }
  const float inv = 1.f / lsum;
  float ss = 0.f;
#pragma unroll
  for (int dt = 0; dt < 2; ++dt)
#pragma unroll
    for (int i = 0; i < 16; ++i) { O[dt][i] *= inv; ss += O[dt][i] * O[dt][i]; }
  ss += __shfl_xor(ss, 32);
  const int row = out_row0 + w * 32 + r;
  if (h == 0) ((float*)(p.ws + OFF_SSA))[(size_t)row * 8 + head] = ss;
  const float* gg = p.in[I_GGRP] + l * 768 + head * 64;
  bfr* Y = (bfr*)(p.ws + R_YATT) + (size_t)row * 512 + head * 64;
#pragma unroll
  for (int dt = 0; dt < 2; ++dt)
#pragma unroll
    for (int g = 0; g < 4; ++g) {
      const int d0 = dt * 32 + 8 * g + 4 * h;
      u32x2 o;
      o[0] = pack2(O[dt][4 * g + 0] * gg[d0 + 0], O[dt][4 * g + 1] * gg[d0 + 1]);
      o[1] = pack2(O[dt][4 * g + 2] * gg[d0 + 2], O[dt][4 * g + 3] * gg[d0 + 3]);
      *(u32x2*)(Y + d0) = o;
    }
  __syncthreads();
}


DI void attn_merge_item(const Params& p, int l, int sidx) {
  const int tid = opaque(threadIdx.x);
  const int a = N_ATT_FULL + sidx;
  const int qb = a >> 4, bh = a & 15, b = bh >> 3, hd = bh & 7;
  const int rowl = tid >> 1, half = tid & 1;
  const float2* ML = (const float2*)(p.ws + OFF_ML);
  const float* PO = (const float*)(p.ws + R_PO);
  float2 ml[4]; float M = -1e30f;
#pragma unroll
  for (int kq = 0; kq < 4; ++kq) { ml[kq] = ML[(size_t)(sidx * 4 + kq) * 128 + rowl]; M = fmaxf(M, ml[kq].x); }
  float wgt[4], L = 0.f;
#pragma unroll
  for (int kq = 0; kq < 4; ++kq) { wgt[kq] = __builtin_amdgcn_exp2f(ml[kq].x - M); L += ml[kq].y * wgt[kq]; }
  const float inv = 1.f / L;
  float o[32];
#pragma unroll
  for (int i = 0; i < 32; ++i) o[i] = 0.f;
#pragma unroll
  for (int kq = 0; kq < 4; ++kq) {
    const float* src = PO + ((size_t)(sidx * 4 + kq) * 128 + rowl) * 64 + half * 32;
#pragma unroll
    for (int q = 0; q < 8; ++q) {
      const float4 v = *(const float4*)(src + q * 4);
      o[q * 4] += v.x * wgt[kq]; o[q * 4 + 1] += v.y * wgt[kq]; o[q * 4 + 2] += v.z * wgt[kq]; o[q * 4 + 3] += v.w * wgt[kq];
    }
  }
  float ss = 0.f;
#pragma unroll
  for (int i = 0; i < 32; ++i) { o[i] *= inv; ss += o[i] * o[i]; }
  ss += __shfl_xor(ss, 1);
  const size_t row = (size_t)b * SEQ + qb * 128 + rowl;
  if (half == 0) ((float*)(p.ws + OFF_SSA))[row * 8 + hd] = ss;
  const float* gg = p.in[I_GGRP] + l * 768 + hd * 64 + half * 32;
  bfr* Y = (bfr*)(p.ws + R_YATT) + row * 512 + hd * 64 + half * 32;
#pragma unroll
  for (int q = 0; q < 4; ++q) {
    u32x4 ov;
#pragma unroll
    for (int k = 0; k < 4; ++k) ov[k] = pack2(o[q * 8 + 2 * k] * gg[q * 8 + 2 * k], o[q * 8 + 2 * k + 1] * gg[q * 8 + 2 * k + 1]);
    *(u32x4*)(Y + q * 8) = ov;
  }
}

#define XB_TMO      128
#define XB_XCNT(j)  (256  + 64 * (j))
#define XB_XSUB(j)  (1280 + 64 * (j))
#define XB_XGEN(j)  (2304 + 64 * (j))
#define XB_TOP      3328
#define XB_TOPGEN   3392
#define XCD_BAR_WORDS 3456
#define XB_SPIN_CAP (1u << 22)
#define LAS __attribute__((address_space(3)))
DI unsigned xb_ld(unsigned* p) { return __hip_atomic_load(p, __ATOMIC_RELAXED, __HIP_MEMORY_SCOPE_AGENT); }
DI unsigned xb_add(unsigned* p, unsigned v) { return __hip_atomic_fetch_add(p, v, __ATOMIC_RELAXED, __HIP_MEMORY_SCOPE_AGENT); }
DI unsigned xb_xcc_id() { return (unsigned)__builtin_amdgcn_s_getreg((3 << 11) | 20) & 0xFu; }
#define XB_SPIN(cond, bar) do { unsigned _sp = 0; while (cond) { __builtin_amdgcn_s_sleep(1); \
    if ((++_sp & 255u) == 0u) { if (xb_ld(&(bar)[XB_TMO])) break; if (_sp > XB_SPIN_CAP) { atomicAdd(&(bar)[XB_TMO], 1u); break; } } } } while (0)
struct XcdBarrier { unsigned* bar; unsigned x; volatile LAS unsigned* st; };
DI XcdBarrier xcd_barrier_post(unsigned* bar, volatile LAS unsigned* st) {
  XcdBarrier b; b.bar = bar; b.x = xb_xcc_id(); b.st = st;
  if (threadIdx.x == 0) (void)xb_add(&bar[XB_XCNT(b.x)], 1u);
  return b;
}
DI void xcd_barrier_complete(unsigned* bar, unsigned x, unsigned& nloc, unsigned& nx) {
  const unsigned G = gridDim.x * gridDim.y * gridDim.z;
  unsigned sum, cnt, mine, sp = 0u;
  for (;;) {
    sum = 0u; cnt = 0u; mine = 0u;
#pragma unroll
    for (unsigned j = 0; j < 16; ++j) { const unsigned c = xb_ld(&bar[XB_XCNT(j)]); sum += c; cnt += (c > 0u) ? 1u : 0u; mine = (j == x) ? c : mine; }
    if (sum == G) break;
    __builtin_amdgcn_s_sleep(1);
    if ((++sp & 255u) == 0u) { if (xb_ld(&bar[XB_TMO])) break; if (sp > XB_SPIN_CAP) { atomicAdd(&bar[XB_TMO], 1u); break; } }
  }
  nloc = mine > 0u ? mine : 1u; nx = cnt > 0u ? cnt : 1u;
}
DI void xcd_barrier(const XcdBarrier& b) {
  asm volatile("s_waitcnt vmcnt(0)" ::: "memory");
  __syncthreads();
  if (threadIdx.x == 0) {
    unsigned* bar = b.bar;
    __builtin_amdgcn_s_waitcnt(0);
    unsigned nloc = b.st[0], nx = b.st[1];
    if (nloc == 0u) { xcd_barrier_complete(bar, b.x, nloc, nx); b.st[0] = nloc; b.st[1] = nx; }
    const unsigned old = xb_add(&bar[XB_XSUB(b.x)], 1u);
    const unsigned gen = old / nloc;
    if (old + 1u == (gen + 1u) * nloc) {
      __builtin_amdgcn_fence(__ATOMIC_RELEASE, "agent");
      asm volatile("s_waitcnt vmcnt(0)" ::: "memory");
      const unsigned og = xb_add(&bar[XB_TOP], 1u);
      const unsigned tg = og / nx;
      if (og + 1u == (tg + 1u) * nx) xb_add(&bar[XB_TOPGEN], 1u);
      else XB_SPIN(xb_ld(&bar[XB_TOPGEN]) == tg, bar);
      __builtin_amdgcn_fence(__ATOMIC_ACQUIRE, "agent");
      xb_add(&bar[XB_XGEN(b.x)], 1u);
      asm volatile("s_waitcnt vmcnt(0)" ::: "memory");
    } else {
      XB_SPIN(xb_ld(&bar[XB_XGEN(b.x)]) == gen, bar);
      __builtin_amdgcn_fence(__ATOMIC_ACQUIRE, "agent");
      asm volatile("s_waitcnt vmcnt(0)" ::: "memory");
    }
  }
  __syncthreads();
}

constexpr int SMEM_BYTES = 60 * 1024;

__global__ void __launch_bounds__(256, 2) mega(Params p) {
  cg::grid_group grid = cg::this_grid();
  __shared__ __attribute__((aligned(16))) char smem[SMEM_BYTES];
  __shared__ int s_item;
  const int tid = opaque(threadIdx.x), lane = tid & 63, w = tid >> 6;
  const int G = gridDim.x, bid = blockIdx.x;
  int* cnt = (int*)(p.ws + OFF_CNT);
  unsigned* bar = (unsigned*)(p.ws + OFF_BAR);
  __shared__ uint4 xb_words;
  if (tid == 0) xb_words = make_uint4(0u, 0u, 0u, 0u);

  __syncthreads();
  XcdBarrier xb = xcd_barrier_post(bar, (volatile LAS unsigned*)&xb_words);
  if (p.out == nullptr) grid.sync();
  for (int it = bid; it < N_WCONV + N_MOD + N_ROPE + N_WL; it += G) phase0_item(p, (it < N_MOD + N_ROPE + N_WL) ? N_WCONV + it : it - (N_MOD + N_ROPE + N_WL), smem);
  xcd_barrier(xb);
  for (int rb = bid; rb < MTOT / 8; rb += G) rownorm_phase(p, 0, 0, rb);
  xcd_barrier(xb);

  for (int l = 0; l < 2; ++l) {
    const int mt_rows = (l == 0) ? MTOT : MLAT;
    {
      const bfr* A = (const bfr*)(p.ws + R_H);
      const bfr* Wt = (const bfr*)(p.ws + OFF_WIN) + (size_t)l * INP * D;
      for (int rep = 0; rep < REP_GEMM; ++rep) gemm_phase<EPI_IN, 4>(p, l, A, D, nullptr, Wt, D, INP / 128, MTOT, nullptr, 0, smem);
    }
    xcd_barrier(xb);
    {
      const int n1 = 2 * NCH * 4, n2 = MTOT / 16;
      for (int it = bid; it < n1 + n2; it += G) {
        if (it < n1) lru_item<false>(p, l, it, smem); else conv_item(p, l, it - n1);
      }
    }
    xcd_barrier(xb);
    {
      const int n1 = 16 * NCH;
      for (int it = bid; it < n1 + 4; it += G) {
        if (it < 4) lru_prefix_item(p, it); else dn_prep_item(p, it - 4, smem);
      }
    }
    xcd_barrier(xb);
    {
      const int n_scan = 16, n_full = N_ATT_FULL, n_part = N_ATT_SPLIT * 4, n_catt = (l == 0) ? 2 * 8 * 2 : 0;
      const int ntot = n_scan + n_full + n_part + n_catt;
      for (;;) {
        if (tid == 0) s_item = atomicAdd(&cnt[l], 1);
        __syncthreads();
        const int it = s_item;
        __syncthreads();
        if (it >= ntot) break;
        if (it < n_scan) dn_chain_item(p, it);
        else if (it < n_scan + n_full + n_part) {
          int a, part = -1, kbeg = 0, nkeys = LK;
          if (it < n_scan + n_full) a = it - n_scan;
          else { const int q = it - n_scan - n_full; a = N_ATT_FULL + (q >> 2); part = q; kbeg = (q & 3) * 2112 - (q & 1) * 64; nkeys = 2048 + (q & 1) * 128; }
          const int qb = a >> 4, bh = a & 15, b = bh >> 3, hd = bh & 7;
          const bfr* Qp = (const bfr*)(p.ws + R_Q) + ((size_t)(b * 8 + hd) * SEQ + qb * 128) * 64;
          const bfr* Kp = (const bfr*)(p.ws + R_K) + (size_t)(b * 2 + (hd >> 2)) * LK * 64;
          const bfr* Vp = (const bfr*)(p.ws + R_VT) + (size_t)(b * 2 + (hd >> 2)) * 64 * LK;
          attn_item(p, l, Qp, Kp, Vp, kbeg, nkeys, b * SEQ + qb * 128, hd, part, smem);
        } else {
          const int a = it - n_scan - n_full - n_part;
          const int qb = a & 1, bh = a >> 1, b = bh >> 3, hd = bh & 7;
          const bfr* Qp = (const bfr*)(p.ws + R_Q) + (size_t)MLAT * 512 + ((size_t)(b * 8 + hd) * CTX + qb * 128) * 64;
          const bfr* Kp = (const bfr*)(p.ws + R_K) + (size_t)(b * 2 + (hd >> 2)) * LK * 64;
          const bfr* Vp = (const bfr*)(p.ws + R_VT) + (size_t)(b * 2 + (hd >> 2)) * 64 * LK;
          attn_item(p, l, Qp, Kp, Vp, 0, CTX, MLAT + b * CTX + qb * 128, hd, -1, smem);
        }
      }
    }
    xcd_barrier(xb);
    {
      const int n1 = 2 * NCH * 4, n2 = 8 * NCH, n3 = N_ATT_SPLIT;
      for (;;) {
        if (tid == 0) s_item = atomicAdd(&cnt[6 + l], 1);
        __syncthreads();
        const int it = s_item;
        __syncthreads();
        if (it >= n1 + n2 + n3) break;
        if (it < n1) lru_item<true>(p, l, it, smem);
        else if (it < n1 + n2) dn_out_item(p, l, it - n1, smem);
        else attn_merge_item(p, l, it - n1 - n2);
      }
    }
    xcd_barrier(xb);
    {
      const bfr* A = (const bfr*)(p.ws + R_YATT);
      const bfr* A2 = (const bfr*)(p.ws + R_YREST);
      const bfr* Wt = (const bfr*)(p.ws + OFF_WOUT) + (size_t)l * D * D;
      for (int rep = 0; rep < REP_GEMM; ++rep) gemm_phase<EPI_OUTPROJ, 2>(p, l, A, 512, A2, Wt, D, D / 128, mt_rows, (float*)(p.ws + R_MIX), D, smem);
    }
    xcd_barrier(xb);
    for (int rep = 0; rep < REP_NORM; ++rep) for (int rb = bid; rb < mt_rows / 8; rb += G) rownorm_phase(p, l, 1, rb);
    xcd_barrier(xb);
    {
      const bfr* A = (const bfr*)(p.ws + R_H);
      const bfr* Wt = (const bfr*)(p.ws + OFF_WF1) + (size_t)l * 2 * FH * D;
      for (int rep = 0; rep < REP_GEMM; ++rep) gemm_phase<EPI_SWIGLU, 4>(p, l, A, D, nullptr, Wt, D, 2 * FH / 128, mt_rows, (float*)(p.ws + R_G), FH, smem);
    }
    xcd_barrier(xb);
    {
      const bfr* A = (const bfr*)(p.ws + R_G);
      const bfr* Wt = (const bfr*)(p.ws + OFF_WF2) + (size_t)l * D * FH;
      for (int rep = 0; rep < REP_GEMM; ++rep) gemm_phase<EPI_F32, 4>(p, l, A, FH, nullptr, Wt, FH, D / 128, mt_rows, (float*)(p.ws + R_F), D, smem);
    }
    xcd_barrier(xb);
    for (int rb = bid; rb < mt_rows / 8; rb += G) rownorm_phase(p, l, 2, rb);
    if (l == 0) xcd_barrier(xb);
  }
}

extern "C" void kernel_launch(void* const* d_in, const int* in_sizes, int n_in, void* d_out, int out_size, void* d_ws, size_t ws_size, hipStream_t stream) {
  static int grid_blocks = 0;
  if (!grid_blocks) {
    int dev = 0, cus = 0, per_cu = 0;
    hipGetDevice(&dev);
    hipDeviceGetAttribute(&cus, hipDeviceAttributeMultiprocessorCount, dev);
    hipOccupancyMaxActiveBlocksPerMultiprocessor(&per_cu, mega, 256, 0);
    if (per_cu > 2) per_cu = 2;
    if (per_cu < 1) per_cu = 1;
    grid_blocks = cus * per_cu;
  }
  if (ws_size < WS_NEED) fprintf(stderr, "workspace too small: %zu < %zu\n", ws_size, (size_t)WS_NEED);
  Params p{};
  for (int i = 0; i < 24; ++i) p.in[i] = (const float*)d_in[i];
  p.out = (float*)d_out;
  p.ws = (char*)d_ws;
  hipMemsetAsync((char*)d_ws + OFF_CNT, 0, 256 + 16384, stream);
  void* args[] = {&p};
  hipError_t e = hipLaunchCooperativeKernel((void*)mega, dim3(grid_blocks), dim3(256), args, 0, stream);
  if (e != hipSuccess) fprintf(stderr, "cooperative launch failed: %s (grid %d)\n", hipGetErrorString(e), grid_blocks);
}
```

```cpp
#include <hip/hip_runtime.h>
#include <hip/hip_cooperative_groups.h>
#include <cstdio>
namespace cg = cooperative_groups;

#define DI __device__ __forceinline__
typedef unsigned short bfr;
using bf16x8 = __attribute__((ext_vector_type(8))) short;
using f32x16 = __attribute__((ext_vector_type(16))) float;
using u32x4 = __attribute__((ext_vector_type(4))) unsigned;
using u32x2 = __attribute__((ext_vector_type(2))) unsigned;
#define MFMA(a, b, c) __builtin_amdgcn_mfma_f32_32x32x16_bf16((a), (b), (c), 0, 0, 0)

#ifndef REP_GEMM
#define REP_GEMM 1
#endif
#ifndef REP_ATT
#define REP_ATT 1
#endif
#ifndef REP_P0
#define REP_P0 1
#endif
#ifndef REP_T3
#define REP_T3 1
#endif
#ifndef REP_T4
#define REP_T4 1
#endif
#ifndef REP_T6
#define REP_T6 1
#endif
#ifndef REP_NORM
#define REP_NORM 1
#endif
#ifndef REP_SCAN
#define REP_SCAN 1
#endif
constexpr int D = 1024, NB = 2, SEQ = 8192, CTX = 256;
constexpr int MLAT = NB * SEQ, MCTX = NB * CTX, MTOT = MLAT + MCTX;
constexpr int LK = SEQ + CTX;
constexpr int PC = 1024;
constexpr int INP = 2432;
constexpr int FH = 2816;
constexpr int NCH = 132;
constexpr float EPS = 1e-6f;
constexpr int N_ATT_FULL = 960, N_ATT_SPLIT = 64;
constexpr float QSCALE = 0.125f * 1.4426950408889634f;

enum { I_X = 0, I_C, I_CTX, I_CCTX, I_WADA, I_BADA, I_GNORM, I_WIN, I_GQK, I_LCW, I_LCB, I_LWR, I_LBR, I_LWI, I_LBI,
       I_LLAM, I_DCW, I_DALOG, I_DDT, I_GDN, I_GGRP, I_WOUT, I_WF1, I_WF2 };

constexpr size_t SZ_WIN = 2ull * INP * D * 2, SZ_WOUT = 2ull * D * D * 2, SZ_WF1 = 2ull * 2 * FH * D * 2, SZ_WF2 = 2ull * D * FH * 2;
constexpr size_t OFF_WIN = 0, OFF_WOUT = OFF_WIN + SZ_WIN, OFF_WF1 = OFF_WOUT + SZ_WOUT, OFF_WF2 = OFF_WF1 + SZ_WF1;
constexpr size_t OFF_MOD = OFF_WF2 + SZ_WF2;
constexpr size_t OFF_CTXB = OFF_MOD + 2ull * 3 * 6144 * 4;
constexpr size_t OFF_GB = OFF_CTXB + 512ull * 1024 * 4;
constexpr size_t OFF_SSA = OFF_GB + (size_t)MTOT * 16 * 4;
constexpr size_t OFF_SSL = OFF_SSA + (size_t)MTOT * 8 * 4;
constexpr size_t OFF_CAR = OFF_SSL + (size_t)MTOT * 4 * 4;
constexpr size_t OFF_ROPE = OFF_CAR + 2ull * 2 * NCH * 256 * 2 * 4;
constexpr size_t OFF_GT = OFF_ROPE + 8192ull * 32 * 8;
constexpr size_t OFF_WL = OFF_GT + 2112ull * 4 + 256;
constexpr size_t OFF_HIN = OFF_WL + 32ull * 4096 * 2;
constexpr size_t OFF_ML = OFF_HIN + 2ull * 2 * NCH * 256 * 4;
constexpr size_t OFF_CNT = OFF_ML + 256ull * 128 * 8;
constexpr size_t OFF_BAR = OFF_CNT + 256;
constexpr size_t OFF_R = OFF_BAR + 16384;
constexpr size_t U = (size_t)MTOT * 1024 * 2;
constexpr size_t R_H = OFF_R;
constexpr size_t R_XR = OFF_R;
constexpr size_t R_DNQKV = OFF_R + U / 4;
constexpr size_t R_YREST = OFF_R + U / 2;
constexpr size_t R_Q = OFF_R + U;
constexpr size_t R_K = OFF_R + U + U / 2;
constexpr size_t R_VT = R_K + U / 8;
constexpr size_t R_P = OFF_R + 7 * U / 4;
constexpr size_t R_SJ = OFF_R + 7 * U / 4;
constexpr size_t R_YATT = OFF_R + 9 * U / 4;
constexpr size_t R_GZ = OFF_R + 11 * U / 4;
constexpr size_t R_UWA = OFF_R + 13 * U / 4;
constexpr size_t R_MIX = OFF_R + 13 * U / 4;
constexpr size_t R_G = OFF_R + U;
constexpr size_t R_F = OFF_R + 15 * U / 4;
constexpr size_t R_PO = OFF_R + 23 * U / 4;
constexpr size_t WS_NEED = OFF_R + 6 * U;

struct Params { const float* in[24]; float* out; char* ws; };

DI int opaque(int v) { asm volatile("" : "+v"(v)); return v; }
DI float bf2f(bfr u) { return __uint_as_float(((unsigned)u) << 16); }
typedef __attribute__((ext_vector_type(2))) float f32x2_t;
typedef __attribute__((ext_vector_type(2))) __bf16 bf16x2_t;
DI unsigned pack2(float a, float b) { f32x2_t v = {a, b}; bf16x2_t r = __builtin_convertvector(v, bf16x2_t); return __builtin_bit_cast(unsigned, r); }
DI bfr f2bf(float x) { return (bfr)(pack2(x, 0.f) & 0xffffu); }
DI float lo_bf(unsigned u) { return __uint_as_float(u << 16); }
DI float hi_bf(unsigned u) { return __uint_as_float(u & 0xffff0000u); }
DI float wave_sum(float v) {
#pragma unroll
  for (int o = 32; o; o >>= 1) v += __shfl_xor(v, o);
  return v;
}
DI float sigmoidf_(float x) { return __builtin_amdgcn_rcpf(1.f + __expf(-x)); }
DI float siluf_(float x) { return x * __builtin_amdgcn_rcpf(1.f + __expf(-x)); }
DI float softplusf_(float x) { return x > 20.f ? x : log1pf(expf(x)); }
DI float geluf_(float x) { return 0.5f * x * (1.f + tanhf(0.7978845608028654f * (x + 0.044715f * x * x * x))); }
DI float dpp_swap1(float v) { return __int_as_float(__builtin_amdgcn_mov_dpp(__float_as_int(v), 0xB1, 0xF, 0xF, true)); }
DI void store_pair_bf16(bfr* rowa, bfr* rowb, int col, int odd, float a, float b) {
  const float pa = dpp_swap1(a), pb = dpp_swap1(b);
  bfr* ptr = odd ? rowb + col - 1 : rowa + col;
  const unsigned val = odd ? pack2(pb, b) : pack2(a, pa);
  *(unsigned*)ptr = val;
}
DI int crow(int i, int h) { return (i & 3) + 8 * (i >> 2) + 4 * h; }
DI bf16x8 pack_step(const f32x16& x, int s) {
  u32x4 p;
  p[0] = pack2(x[8 * s + 0], x[8 * s + 1]); p[1] = pack2(x[8 * s + 2], x[8 * s + 3]);
  p[2] = pack2(x[8 * s + 4], x[8 * s + 5]); p[3] = pack2(x[8 * s + 6], x[8 * s + 7]);
  return __builtin_bit_cast(bf16x8, p);
}
DI int dn_row(int b, int dir, int j, int c) {
  if (j < 4) { int p = j * 64 + c; int t = dir ? (CTX - 1 - p) : p; return MLAT + b * CTX + t; }
  int p = (j - 4) * 64 + c; int t = dir ? (SEQ - 1 - p) : p; return b * SEQ + t;
}

DI void wconv_tile(const float* __restrict__ W, int K, int N, bfr* __restrict__ Wt, int n0, int srcA, int srcB, int nvalid, int k0, float* tile) {
  const int tid = opaque(threadIdx.x);
  const int c = tid & 63, kr = tid >> 6;
  const int scol = (c < 32) ? srcA + c : srcB + (c - 32);
  float v[16];
#pragma unroll
  for (int q = 0; q < 16; ++q) v[q] = (c < nvalid) ? W[(size_t)(k0 + kr + q * 4) * N + scol] : 0.f;
#pragma unroll
  for (int q = 0; q < 16; ++q) tile[(kr + q * 4) * 65 + c] = v[q];
  __syncthreads();
  const int n = tid >> 2, kc = (tid & 3) * 16;
  u32x4 o0, o1;
#pragma unroll
  for (int j = 0; j < 4; ++j) {
    o0[j] = pack2(tile[(kc + 2 * j) * 65 + n], tile[(kc + 2 * j + 1) * 65 + n]);
    o1[j] = pack2(tile[(kc + 8 + 2 * j) * 65 + n], tile[(kc + 8 + 2 * j + 1) * 65 + n]);
  }
  *(u32x4*)&Wt[(size_t)(n0 + n) * K + k0 + kc] = o0;
  *(u32x4*)&Wt[(size_t)(n0 + n) * K + k0 + kc + 8] = o1;
  __syncthreads();
}

constexpr int WC_IN = 38 * 16, WC_OUT = 16 * 16, WC_F1 = 88 * 16, WC_F2 = 16 * 44;
constexpr int WC_LAYER = WC_IN + WC_OUT + WC_F1 + WC_F2;
constexpr int N_WCONV = 2 * WC_LAYER;
constexpr int N_MOD = 192;
constexpr int N_ROPE = 64;
constexpr int N_WL = 32;

DI void phase0_item(const Params& p, int item, char* smem) {
  float* fs = (float*)smem;
  if (item < N_WCONV) {
    int l = item / WC_LAYER, it = item % WC_LAYER;
    if (it < WC_IN) {
      int nt = it / 16, kt = it % 16;
      int nv = 2320 - nt * 64; nv = nv < 0 ? 0 : (nv > 64 ? 64 : nv);
      wconv_tile(p.in[I_WIN] + (size_t)l * D * 2320, D, 2320, (bfr*)(p.ws + OFF_WIN) + (size_t)l * INP * D, nt * 64, nt * 64, nt * 64 + 32, nv, kt * 64, fs);
    } else if (it < WC_IN + WC_OUT) {
      it -= WC_IN; int nt = it / 16, kt = it % 16;
      wconv_tile(p.in[I_WOUT] + (size_t)l * D * D, D, D, (bfr*)(p.ws + OFF_WOUT) + (size_t)l * D * D, nt * 64, nt * 64, nt * 64 + 32, 64, kt * 64, fs);
    } else if (it < WC_IN + WC_OUT + WC_F1) {
      it -= WC_IN + WC_OUT; int ot = it / 16, kt = it % 16;
      int blk = ot >> 1, wn = ot & 1;
      wconv_tile(p.in[I_WF1] + (size_t)l * D * 2 * FH, D, 2 * FH, (bfr*)(p.ws + OFF_WF1) + (size_t)l * 2 * FH * D, ot * 64, blk * 64 + wn * 32, FH + blk * 64 + wn * 32, 64, kt * 64, fs);
    } else {
      it -= WC_IN + WC_OUT + WC_F1; int nt = it / 44, kt = it % 44;
      wconv_tile(p.in[I_WF2] + (size_t)l * FH * D, FH, D, (bfr*)(p.ws + OFF_WF2) + (size_t)l * D * FH, nt * 64, nt * 64, nt * 64 + 32, 64, kt * 64, fs);
    }
  } else if (item >= N_WCONV + N_MOD + N_ROPE) {
    const int tid = opaque(threadIdx.x);
    const int m = item - (N_WCONV + N_MOD + N_ROPE);
    const int kb = m & 3, gate = (m >> 2) & 1, ld = m >> 3;
    const float* W = p.in[gate ? I_LWI : I_LWR] + ((size_t)ld * 4 + kb) * 4096;
    bfr* dst = (bfr*)(p.ws + OFF_WL) + (size_t)m * 4096;
    const int e = tid >> 2, d0 = (tid & 3) * 16;
    u32x4 o0, o1;
#pragma unroll
    for (int i = 0; i < 4; ++i) {
      o0[i] = pack2(W[(d0 + 2 * i) * 64 + e], W[(d0 + 2 * i + 1) * 64 + e]);
      o1[i] = pack2(W[(d0 + 8 + 2 * i) * 64 + e], W[(d0 + 8 + 2 * i + 1) * 64 + e]);
    }
    *(u32x4*)(dst + e * 64 + d0) = o0; *(u32x4*)(dst + e * 64 + d0 + 8) = o1;
  } else if (item >= N_WCONV + N_MOD) {
    const int tid = opaque(threadIdx.x);
    float2* rope = (float2*)(p.ws + OFF_ROPE);
    const int base = (item - N_WCONV - N_MOD) * 4096;
    for (int q = 0; q < 16; ++q) {
      const int idx = base + q * 256 + tid;
      const int t = idx >> 5, i = idx & 31, f = i & 15;
      const float pos = (i < 16) ? (float)(t >> 6) : (float)(t & 63);
      const float inv = exp2f(-(float)f * (13.287712379549449f / 16.f));
      float sn, cs;
      sincosf(pos * inv, &sn, &cs);
      rope[idx] = make_float2(cs, sn);
    }
  } else {
    int m = item - N_WCONV;
    int l = m / 96, j0 = (m % 96) * 64;
    const int tid = opaque(threadIdx.x);
    for (int i = tid; i < 3072; i += 256) {
      int v = i >> 10, k = i & 1023;
      float cv = (v < 2) ? p.in[I_C][v * 1024 + k] : p.in[I_CCTX][k];
      fs[i] = siluf_(cv);
    }
    __syncthreads();
    const int c4 = (tid & 15) * 4, ks = tid >> 4;
    float4 a0 = make_float4(0.f, 0.f, 0.f, 0.f), a1 = a0, a2 = a0;
    const float* w = p.in[I_WADA] + (size_t)l * D * 6144 + j0 + c4;
#pragma unroll 16
    for (int k = ks * 64; k < ks * 64 + 64; ++k) {
      const float4 wv = *(const float4*)(w + (size_t)k * 6144);
      const float s0 = fs[k], s1 = fs[1024 + k], s2 = fs[2048 + k];
      a0.x += s0 * wv.x; a0.y += s0 * wv.y; a0.z += s0 * wv.z; a0.w += s0 * wv.w;
      a1.x += s1 * wv.x; a1.y += s1 * wv.y; a1.z += s1 * wv.z; a1.w += s1 * wv.w;
      a2.x += s2 * wv.x; a2.y += s2 * wv.y; a2.z += s2 * wv.z; a2.w += s2 * wv.w;
    }
    float* red = fs + 3072;
    *(float4*)&red[(ks * 3 + 0) * 64 + c4] = a0; *(float4*)&red[(ks * 3 + 1) * 64 + c4] = a1; *(float4*)&red[(ks * 3 + 2) * 64 + c4] = a2;
    __syncthreads();
    if (tid < 192) {
      int v = tid >> 6, cc = tid & 63;
      float s = p.in[I_BADA][l * 6144 + j0 + cc];
      for (int q = 0; q < 16; ++q) s += red[(q * 3 + v) * 64 + cc];
      ((float*)(p.ws + OFF_MOD))[(l * 3 + v) * 6144 + j0 + cc] = s;
    }
    __syncthreads();
  }
}

struct RowJob { const float* xin; float* xout; const bfr* br; const float* gbr; const float* gate; const float* gn; const float* scn; const float* shn; bfr* hout; };

DI void resid_norm_rows2(const RowJob (&J)[2], int lane) {
  float4 xv[2][4];
#pragma unroll
  for (int j = 0; j < 2; ++j)
#pragma unroll
    for (int i = 0; i < 4; ++i) xv[j][i] = *(const float4*)(J[j].xin + lane * 4 + i * 256);
  if (J[0].br) {
    float4 bv[2][4]; float ss[2];
#pragma unroll
    for (int j = 0; j < 2; ++j) {
      ss[j] = 0.f;
#pragma unroll
      for (int i = 0; i < 4; ++i) {
        const u32x2 bb = *(const u32x2*)(J[j].br + lane * 4 + i * 256);
        bv[j][i] = make_float4(lo_bf(bb[0]), hi_bf(bb[0]), lo_bf(bb[1]), hi_bf(bb[1]));
        ss[j] += bv[j][i].x * bv[j][i].x + bv[j][i].y * bv[j][i].y + bv[j][i].z * bv[j][i].z + bv[j][i].w * bv[j][i].w;
      }
    }
#pragma unroll
    for (int o = 32; o; o >>= 1) { ss[0] += __shfl_xor(ss[0], o); ss[1] += __shfl_xor(ss[1], o); }
#pragma unroll
    for (int j = 0; j < 2; ++j) {
      const float s = rsqrtf(ss[j] * (1.f / 1024.f) + EPS);
#pragma unroll
      for (int i = 0; i < 4; ++i) {
        const float4 g = *(const float4*)(J[j].gbr + lane * 4 + i * 256), gt = *(const float4*)(J[j].gate + lane * 4 + i * 256);
        xv[j][i].x += gt.x * (bv[j][i].x * s * g.x); xv[j][i].y += gt.y * (bv[j][i].y * s * g.y);
        xv[j][i].z += gt.z * (bv[j][i].z * s * g.z); xv[j][i].w += gt.w * (bv[j][i].w * s * g.w);
        *(float4*)(J[j].xout + lane * 4 + i * 256) = xv[j][i];
      }
    }
  }
  if (J[0].hout) {
    float ss[2];
#pragma unroll
    for (int j = 0; j < 2; ++j) {
      ss[j] = 0.f;
#pragma unroll
      for (int i = 0; i < 4; ++i) ss[j] += xv[j][i].x * xv[j][i].x + xv[j][i].y * xv[j][i].y + xv[j][i].z * xv[j][i].z + xv[j][i].w * xv[j][i].w;
    }
#pragma unroll
    for (int o = 32; o; o >>= 1) { ss[0] += __shfl_xor(ss[0], o); ss[1] += __shfl_xor(ss[1], o); }
#pragma unroll
    for (int j = 0; j < 2; ++j) {
      const float s = rsqrtf(ss[j] * (1.f / 1024.f) + EPS);
#pragma unroll
      for (int i = 0; i < 4; ++i) {
        const float4 g = *(const float4*)(J[j].gn + lane * 4 + i * 256), sc = *(const float4*)(J[j].scn + lane * 4 + i * 256), sh = *(const float4*)(J[j].shn + lane * 4 + i * 256);
        u32x2 o;
        o[0] = pack2(xv[j][i].x * s * g.x * (1.f + sc.x) + sh.x, xv[j][i].y * s * g.y * (1.f + sc.y) + sh.y);
        o[1] = pack2(xv[j][i].z * s * g.z * (1.f + sc.z) + sh.z, xv[j][i].w * s * g.w * (1.f + sc.w) + sh.w);
        *(u32x2*)(J[j].hout + lane * 4 + i * 256) = o;
      }
    }
  }
}

DI RowJob make_rowjob(const Params& p, int l, int mode, int row) {
  RowJob j;
  const bool isctx = row >= MLAT;
  const int b = isctx ? (row - MLAT) / CTX : row / SEQ;
  const int v = isctx ? 2 : b;
  const float* mod = (const float*)(p.ws + OFF_MOD) + (size_t)(l * 3 + v) * 6144;
  const float* gnorm = p.in[I_GNORM] + (size_t)l * 4 * 1024;
  float* ctxb = (float*)(p.ws + OFF_CTXB);
  bfr* H = (bfr*)(p.ws + R_H) + (size_t)row * 1024;
  if (mode == 0) {
    j.xin = isctx ? p.in[I_CTX] + (size_t)(row - MLAT) * 1024 : p.in[I_X] + (size_t)row * 1024;
    j.xout = nullptr; j.br = nullptr; j.gbr = nullptr; j.gate = nullptr;
    j.gn = gnorm; j.scn = mod + 1024; j.shn = mod; j.hout = H;
  } else if (mode == 1) {
    if (isctx) { j.xin = (l == 0) ? p.in[I_CTX] + (size_t)(row - MLAT) * 1024 : ctxb + (size_t)(row - MLAT) * 1024; j.xout = ctxb + (size_t)(row - MLAT) * 1024; }
    else { j.xin = (l == 0) ? p.in[I_X] + (size_t)row * 1024 : p.out + (size_t)row * 1024; j.xout = p.out + (size_t)row * 1024; }
    j.br = (const bfr*)(p.ws + R_MIX) + (size_t)row * 1024;
    j.gbr = gnorm + 1024; j.gate = mod + 2048; j.gn = gnorm + 2048; j.scn = mod + 4096; j.shn = mod + 3072; j.hout = H;
  } else {
    float* xio = isctx ? ctxb + (size_t)(row - MLAT) * 1024 : p.out + (size_t)row * 1024;
    j.xin = xio; j.xout = xio;
    j.br = (const bfr*)(p.ws + R_F) + (size_t)row * 1024;
    j.gbr = gnorm + 3072; j.gate = mod + 5120;
    if (l == 0) {
      const float* mod2 = (const float*)(p.ws + OFF_MOD) + (size_t)(3 + v) * 6144;
      j.gn = p.in[I_GNORM] + (size_t)4 * 1024; j.scn = mod2 + 1024; j.shn = mod2; j.hout = H;
    } else { j.gn = nullptr; j.scn = nullptr; j.shn = nullptr; j.hout = nullptr; }
  }
  return j;
}
DI void rownorm_phase(const Params& p, int l, int mode, int rb) {
  const int tid_ = opaque(threadIdx.x);
  const int lane = tid_ & 63, row = rb * 8 + (tid_ >> 6);
  RowJob J[2];
  J[0] = make_rowjob(p, l, mode, row);
  J[1] = make_rowjob(p, l, mode, row + 4);
  resid_norm_rows2(J, lane);
}

enum { EPI_IN = 0, EPI_F32 = 1, EPI_SWIGLU = 2, EPI_OUTPROJ = 3 };
constexpr int LDT = 72;

template <int EPI, int MTW>
DI void gemm_tile(const Params& p, int l, const bfr* __restrict__ A, int lda, const bfr* __restrict__ A2, const bfr* __restrict__ Wt, int K, int m0, int n0, float* __restrict__ outf, int ldc, char* smem) {
  constexpr int BM = 64 * MTW;
  constexpr int NA = BM / 32;
  bfr* sA = (bfr*)smem; bfr* sB = sA + BM * LDT;
  float* srow = (float*)(smem + (BM + 128) * LDT * 2);
  const int tid = opaque(threadIdx.x), lane = tid & 63, w = tid >> 6, wm = w >> 1, wn = w & 1, r = lane & 31, h = lane >> 5;
  f32x16 acc[MTW][2];
#pragma unroll
  for (int a = 0; a < MTW; ++a)
#pragma unroll
    for (int b = 0; b < 2; ++b)
#pragma unroll
      for (int i = 0; i < 16; ++i) acc[a][b][i] = 0.f;
  const int lrow = tid >> 3, lkc = (tid & 7) * 8;
  const bfr* ga = A + (size_t)(m0 + lrow) * lda + lkc;
  const bfr* ga2 = (EPI == EPI_OUTPROJ) ? A2 + (size_t)(m0 + lrow) * lda + lkc - 512 : nullptr;
  const bfr* gb = Wt + (size_t)(n0 + lrow) * K + lkc;
  constexpr int NST = (MTW <= 2) ? 2 : 1;
  const int nk = K / 64;
  u32x4 ra0[NA], rb0[4], ra1[NA], rb1[4];
#pragma unroll
  for (int i = 0; i < NA; ++i) ra0[i] = *(const u32x4*)(ga + (size_t)i * 32 * lda);
#pragma unroll
  for (int i = 0; i < 4; ++i) rb0[i] = *(const u32x4*)(gb + (size_t)i * 32 * K);
  if (NST == 2) {
#pragma unroll
    for (int i = 0; i < NA; ++i) ra1[i] = *(const u32x4*)(ga + (size_t)i * 32 * lda + 64);
#pragma unroll
    for (int i = 0; i < 4; ++i) rb1[i] = *(const u32x4*)(gb + (size_t)i * 32 * K + 64);
  }
  if (EPI == EPI_OUTPROJ) {
    if (tid < 128) {
      const float* ssa = (const float*)(p.ws + OFF_SSA) + (size_t)(m0 + tid) * 8;
      const float* ssl = (const float*)(p.ws + OFF_SSL) + (size_t)(m0 + tid) * 4;
      float sa = 0.f, sl = 0.f;
      for (int i = 0; i < 8; ++i) sa += ssa[i];
      for (int i = 0; i < 4; ++i) sl += ssl[i];
      sa = rsqrtf(sa * (1.f / 512.f) + EPS); sl = rsqrtf(sl * (1.f / 256.f) + EPS);
      srow[tid] = sa / sl; srow[128 + tid] = sl;
    }
  }
  auto step = [&](const int kt, u32x4 (&ra)[NA], u32x4 (&rb)[4], const int pf) {
    __syncthreads();
#pragma unroll
    for (int i = 0; i < NA; ++i) *(u32x4*)&sA[(lrow + i * 32) * LDT + lkc] = ra[i];
#pragma unroll
    for (int i = 0; i < 4; ++i) *(u32x4*)&sB[(lrow + i * 32) * LDT + lkc] = rb[i];
    __syncthreads();
    if (pf < nk) {
      const int k0 = pf * 64;
      const bfr* gsrc = (EPI == EPI_OUTPROJ && k0 >= 512) ? ga2 : ga;
#pragma unroll
      for (int i = 0; i < NA; ++i) ra[i] = *(const u32x4*)(gsrc + (size_t)i * 32 * lda + k0);
#pragma unroll
      for (int i = 0; i < 4; ++i) rb[i] = *(const u32x4*)(gb + (size_t)i * 32 * K + k0);
    }
    if (EPI == EPI_OUTPROJ) {
      if (kt == 8 || kt == 12) {
        const float* sr = srow + (kt == 8 ? 0 : 128);
#pragma unroll
        for (int mt = 0; mt < MTW; ++mt)
#pragma unroll
          for (int i = 0; i < 16; ++i) {
            float s = sr[wm * (MTW * 32) + mt * 32 + crow(i, h)];
            acc[mt][0][i] *= s; acc[mt][1][i] *= s;
          }
        __builtin_amdgcn_sched_barrier(0);
      }
    }
    bf16x8 fb[2][2], fa[2][MTW];
    fb[0][0] = *(const bf16x8*)&sB[(wn * 64 + r) * LDT + h * 8];
    fb[0][1] = *(const bf16x8*)&sB[(wn * 64 + 32 + r) * LDT + h * 8];
#pragma unroll
    for (int mt = 0; mt < MTW; ++mt) fa[0][mt] = *(const bf16x8*)&sA[(wm * (MTW * 32) + mt * 32 + r) * LDT + h * 8];
#pragma unroll
    for (int ks = 0; ks < 4; ++ks) {
      const int cur = ks & 1, nxt = cur ^ 1;
      if (ks < 3) {
        fb[nxt][0] = *(const bf16x8*)&sB[(wn * 64 + r) * LDT + (ks + 1) * 16 + h * 8];
        fb[nxt][1] = *(const bf16x8*)&sB[(wn * 64 + 32 + r) * LDT + (ks + 1) * 16 + h * 8];
#pragma unroll
        for (int mt = 0; mt < MTW; ++mt) fa[nxt][mt] = *(const bf16x8*)&sA[(wm * (MTW * 32) + mt * 32 + r) * LDT + (ks + 1) * 16 + h * 8];
      }
#pragma unroll
      for (int mt = 0; mt < MTW; ++mt) {
        acc[mt][0] = MFMA(fa[cur][mt], fb[cur][0], acc[mt][0]); acc[mt][1] = MFMA(fa[cur][mt], fb[cur][1], acc[mt][1]);
      }
    }
    if (MTW >= 2) {
      if (pf < nk) __builtin_amdgcn_sched_group_barrier(0x020, NA + 4, 0);
      __builtin_amdgcn_sched_group_barrier(0x100, MTW + 2, 0);
#pragma unroll
      for (int ks = 0; ks < 3; ++ks) {
#pragma unroll
        for (int q = 0; q < MTW + 2; ++q) { __builtin_amdgcn_sched_group_barrier(0x008, 1, 0); __builtin_amdgcn_sched_group_barrier(0x100, 1, 0); }
        if (MTW > 2) __builtin_amdgcn_sched_group_barrier(0x008, (MTW > 2) ? MTW - 2 : 1, 0);
      }
      __builtin_amdgcn_sched_group_barrier(0x008, 2 * MTW, 0);
    }
  };
  if (NST == 1) {
    for (int kt = 0; kt < nk; ++kt) step(kt, ra0, rb0, kt + 1);
  } else {
    for (int kt = 0; kt < nk; kt += 2) { step(kt, ra0, rb0, kt + 2); step(kt + 1, ra1, rb1, kt + 3); }
  }
  if (EPI == EPI_IN) {
    const int nt = n0 >> 7;
    const bool isctx = m0 >= MLAT;
    const int b = isctx ? (m0 - MLAT) / CTX : m0 / SEQ;
    const int t0 = (isctx ? (m0 - MLAT) % CTX : m0 % SEQ) + wm * (MTW * 32);
    if (nt < 5) {
      const bool isq = nt < 4;
      const int head = isq ? nt * 2 + wn : wn;
      const float* gq = p.in[I_GQK] + l * 128 + (isq ? 0 : 64);
      const float g0 = gq[r], g1 = gq[32 + r];
      const float2* rope = (const float2*)(p.ws + OFF_ROPE);
      bfr* dst;
      if (isq) dst = isctx ? (bfr*)(p.ws + R_Q) + (size_t)MLAT * 512 + ((size_t)(b * 8 + head) * CTX + t0) * 64 : (bfr*)(p.ws + R_Q) + ((size_t)(b * 8 + head) * SEQ + t0) * 64;
      else dst = (bfr*)(p.ws + R_K) + ((size_t)(b * 2 + head) * LK + (isctx ? t0 : CTX + t0)) * 64;
#pragma unroll
      for (int mt = 0; mt < MTW; ++mt)
#pragma unroll
        for (int i = 0; i < 16; ++i) {
          const int rr = mt * 32 + crow(i, h);
          float v0 = acc[mt][0][i], v1 = acc[mt][1][i];
          float ss = v0 * v0 + v1 * v1;
          ss += __shfl_xor(ss, 1); ss += __shfl_xor(ss, 2); ss += __shfl_xor(ss, 4); ss += __shfl_xor(ss, 8); ss += __shfl_xor(ss, 16);
          const float rs = rsqrtf(ss * (1.f / 64.f) + EPS);
          float y0 = v0 * rs * g0, y1 = v1 * rs * g1;
          if (!isctx) {
            const float2 cs = rope[(size_t)(t0 + rr) * 32 + r];
            const float o0 = y0 * cs.x - y1 * cs.y, o1 = y1 * cs.x + y0 * cs.y;
            y0 = o0; y1 = o1;
          }
          if (isq) { y0 *= QSCALE; y1 *= QSCALE; }
          dst[(size_t)rr * 64 + r] = f2bf(y0); dst[(size_t)rr * 64 + 32 + r] = f2bf(y1);
        }
    } else if (nt == 5) {
      bfr* vt = (bfr*)(p.ws + R_VT) + (size_t)(b * 2 + wn) * 64 * LK + (isctx ? t0 : CTX + t0);
#pragma unroll
      for (int mt = 0; mt < MTW; ++mt)
#pragma unroll
        for (int nt2 = 0; nt2 < 2; ++nt2)
#pragma unroll
          for (int g = 0; g < 4; ++g) {
            u32x2 o; o[0] = pack2(acc[mt][nt2][4 * g], acc[mt][nt2][4 * g + 1]); o[1] = pack2(acc[mt][nt2][4 * g + 2], acc[mt][nt2][4 * g + 3]);
            *(u32x2*)(vt + (size_t)(nt2 * 32 + r) * LK + mt * 32 + (g >> 1) * 16 + h * 8 + (g & 1) * 4) = o;
          }
    } else if (nt == 18) {
      if (wn == 0 && r < 16) {
        float* GBp = (float*)(p.ws + OFF_GB);
        const float alog = (r < 8) ? expf(p.in[I_DALOG][l * 8 + r]) : 0.f;
        const float dtb = (r < 8) ? p.in[I_DDT][l * 8 + r] : 0.f;
#pragma unroll
        for (int mt = 0; mt < MTW; ++mt)
#pragma unroll
          for (int i = 0; i < 16; ++i) {
            const int row = m0 + wm * (MTW * 32) + mt * 32 + crow(i, h);
            const float v = acc[mt][0][i];
            GBp[(size_t)row * 16 + r] = (r < 8) ? -alog * softplusf_(v + dtb) : sigmoidf_(v);
          }
      }
    } else {
      const bool is_lg = nt < 8, is_dz = nt >= 16;
      bfr* dstb; int ld, c0;
      if (is_lg) { dstb = (bfr*)(p.ws + R_GZ); ld = 512; c0 = n0 - 768; }
      else if (is_dz) { dstb = (bfr*)(p.ws + R_GZ); ld = 512; c0 = 256 + n0 - 2048; }
      else { dstb = (bfr*)(p.ws + R_P); ld = PC; c0 = n0 - 1024; }
#pragma unroll
      for (int mt = 0; mt < MTW; ++mt)
#pragma unroll
        for (int i = 0; i < 16; i += 2) {
          const size_t rowa = (size_t)(m0 + wm * (MTW * 32) + mt * 32 + crow(i, h));
#pragma unroll
          for (int nt2 = 0; nt2 < 2; ++nt2) {
            float va = acc[mt][nt2][i], vb = acc[mt][nt2][i + 1];
            if (is_lg) { va = geluf_(va); vb = geluf_(vb); } else if (is_dz) { va = siluf_(va); vb = siluf_(vb); }
            store_pair_bf16(dstb + rowa * ld, dstb + (rowa + 1) * ld, c0 + wn * 64 + nt2 * 32 + r, r & 1, va, vb);
          }
        }
    }
    return;
  }
  {
    const int odd = r & 1;
    bfr* ob = (bfr*)outf;
#pragma unroll
    for (int mt = 0; mt < MTW; ++mt) {
#pragma unroll
      for (int i = 0; i < 16; i += 2) {
        const size_t rowa = (size_t)(m0 + wm * (MTW * 32) + mt * 32 + crow(i, h)), rowb = rowa + 1;
        if (EPI == EPI_SWIGLU) {
          const int col = (n0 >> 1) + wn * 32 + r;
          const float va = siluf_(acc[mt][0][i]) * acc[mt][1][i], vb = siluf_(acc[mt][0][i + 1]) * acc[mt][1][i + 1];
          store_pair_bf16(ob + rowa * ldc, ob + rowb * ldc, col, odd, va, vb);
        } else {
#pragma unroll
          for (int nt = 0; nt < 2; ++nt) {
            const int col = n0 + wn * 64 + nt * 32 + r;
            store_pair_bf16(ob + rowa * ldc, ob + rowb * ldc, col, odd, acc[mt][nt][i], acc[mt][nt][i + 1]);
          }
        }
      }
    }
  }
}

template <int EPI, int MTW>
DI void gemm_phase(const Params& p, int l, const bfr* A, int lda, const bfr* A2, const bfr* Wt, int K, int ntn, int mrows, float* outf, int ldc, char* smem) {
  const int G = gridDim.x;
  const int bid = ((G & 7) == 0) ? (int)((blockIdx.x & 7) * (G >> 3) + (blockIdx.x >> 3)) : (int)blockIdx.x;
  constexpr int BM = 64 * MTW;
  const int nb = ntn * (mrows / BM);
  int nfull = (nb / G) * G, rem = nb - nfull;
  if (2 * rem > G) { nfull = nb; rem = 0; }
  const int items = nfull + 2 * rem;
  const int ntm = mrows / BM, gmn = 8 * ntn;
  for (int it = bid; it < items; it += G) {
    const int t = (it < nfull) ? it : nfull + ((it - nfull) >> 1);
    const int grp = t / gmn, first = grp * 8, gsz = (ntm - first < 8) ? ntm - first : 8, wi = t - grp * gmn;
    const int mt_ = first + wi % gsz, nt_ = wi / gsz;
    if (it < nfull) gemm_tile<EPI, MTW>(p, l, A, lda, A2, Wt, K, mt_ * BM, nt_ * 128, outf, ldc, smem);
    else gemm_tile<EPI, MTW / 2>(p, l, A, lda, A2, Wt, K, mt_ * BM + ((it - nfull) & 1) * (BM / 2), nt_ * 128, outf, ldc, smem);
  }
}

DI void conv_item(const Params& p, int l, int it) {
  const int tid = opaque(threadIdx.x);
  const int row0 = it * 16;
  const bool isctx = row0 >= MLAT;
  const int t0 = isctx ? (row0 - MLAT) % CTX : row0 % SEQ;
  const int L = isctx ? CTX : SEQ;
  const int ch4 = tid * 4;
  const bfr* P = (const bfr*)(p.ws + R_P);
  if (tid < 64) return;
  u32x2 xv[19];
#pragma unroll
  for (int k = 0; k < 19; ++k) {
    const int tt = t0 - 1 + k;
    if (tt >= 0 && tt < L) xv[k] = *(const u32x2*)(P + (size_t)(row0 - 1 + k) * PC + ch4);
    else { xv[k][0] = 0u; xv[k][1] = 0u; }
  }
  const bool is_lru = tid < 64;
  float4 wv[4], bias;
  if (is_lru) {
#pragma unroll
    for (int tap = 0; tap < 4; ++tap) wv[tap] = *(const float4*)(p.in[I_LCW] + (size_t)l * 1024 + tap * 256 + ch4);
    bias = *(const float4*)(p.in[I_LCB] + l * 256 + ch4);
  } else {
#pragma unroll
    for (int tap = 0; tap < 4; ++tap) wv[tap] = *(const float4*)(p.in[I_DCW] + (size_t)l * 3072 + tap * 768 + (ch4 - 256));
    bias = make_float4(0.f, 0.f, 0.f, 0.f);
  }
  const bool do_l2 = tid < 192;
#pragma unroll
  for (int rr = 0; rr < 16; ++rr) {
    float4 a = bias;
#pragma unroll
    for (int tap = 0; tap < 4; ++tap) {
      const u32x2 x = xv[rr + tap];
      a.x += wv[tap].x * lo_bf(x[0]); a.y += wv[tap].y * hi_bf(x[0]); a.z += wv[tap].z * lo_bf(x[1]); a.w += wv[tap].w * hi_bf(x[1]);
    }
    u32x2 o;
    if (is_lru) {
      o[0] = pack2(a.x, a.y); o[1] = pack2(a.z, a.w);
      *(u32x2*)((bfr*)(p.ws + R_XR) + (size_t)(row0 + rr) * 256 + ch4) = o;
    } else {
      a.x = siluf_(a.x); a.y = siluf_(a.y); a.z = siluf_(a.z); a.w = siluf_(a.w);
      if (do_l2) {
        float ss = a.x * a.x + a.y * a.y + a.z * a.z + a.w * a.w;
        ss += __shfl_xor(ss, 1); ss += __shfl_xor(ss, 2); ss += __shfl_xor(ss, 4); ss += __shfl_xor(ss, 8);
        const float rs = rsqrtf(ss + EPS);
        a.x *= rs; a.y *= rs; a.z *= rs; a.w *= rs;
      }
      o[0] = pack2(a.x, a.y); o[1] = pack2(a.z, a.w);
      *(u32x2*)((bfr*)(p.ws + R_DNQKV) + (size_t)(row0 + rr) * 768 + (ch4 - 256)) = o;
    }
  }
}

DI bf16x8 afrag(const bfr* M, int row, int k0) {
  u32x2 lo = *(const u32x2*)&M[row * LDT + k0];
  u32x2 hi = *(const u32x2*)&M[row * LDT + k0 + 8];
  u32x4 v; v[0] = lo[0]; v[1] = lo[1]; v[2] = hi[0]; v[3] = hi[1];
  return __builtin_bit_cast(bf16x8, v);
}

DI void dn_prep_item(const Params& p, int item, char* smem) {
  float* sx = (float*)smem;
  bfr* sqb = (bfr*)smem;
  bfr* sAt = (bfr*)(smem + 9216);
  bfr* skb = (bfr*)(smem + 32768);
  float* sLT = (float*)(smem + 32768 + 9216);
  float* sgc = (float*)(smem + 32768 + 9216 + 17408);
  float* sbeta = sgc + 64;
  const int tid = opaque(threadIdx.x), lane = tid & 63, w = tid >> 6, r = lane & 31, h = lane >> 5;
  const int j = item % NCH; int rest = item / NCH; const int dir = rest & 1; rest >>= 1; const int hh = rest & 3; const int b = rest >> 2;
  const bfr* DQ = (const bfr*)(p.ws + R_DNQKV);
  const float* GB = (const float*)(p.ws + OFF_GB);
  bfr* UW = (bfr*)(p.ws + R_UWA) + (size_t)item * 5 * 4096;
  {
    const int c = tid >> 2, e0 = (tid & 3) * 16;
    const int row = dn_row(b, dir, j, c);
    const bfr* srcp = DQ + (size_t)row * 768 + hh * 64 + e0;
    *(u32x4*)&sqb[c * LDT + e0] = *(const u32x4*)srcp; *(u32x4*)&sqb[c * LDT + e0 + 8] = *(const u32x4*)(srcp + 8);
    *(u32x4*)&skb[c * LDT + e0] = *(const u32x4*)(srcp + 256); *(u32x4*)&skb[c * LDT + e0 + 8] = *(const u32x4*)(srcp + 256 + 8);
    if (tid < 64) {
      const int rw = dn_row(b, dir, j, tid);
      float g = GB[(size_t)rw * 16 + dir * 4 + hh];
#pragma unroll
      for (int o = 1; o < 64; o <<= 1) { float t = __shfl_up(g, o); if (tid >= o) g += t; }
      sgc[tid] = g;
      sbeta[tid] = GB[(size_t)rw * 16 + 8 + dir * 4 + hh];
    }
  }
  __syncthreads();
  {
    const int ct = w >> 1, kt = w & 1;
    f32x16 KK, QK;
#pragma unroll
    for (int i = 0; i < 16; ++i) { KK[i] = 0.f; QK[i] = 0.f; }
#pragma unroll
    for (int ks = 0; ks < 4; ++ks) {
      const bf16x8 ak = *(const bf16x8*)&skb[(ct * 32 + r) * LDT + ks * 16 + h * 8];
      const bf16x8 aq = *(const bf16x8*)&sqb[(ct * 32 + r) * LDT + ks * 16 + h * 8];
      const bf16x8 bk = *(const bf16x8*)&skb[(kt * 32 + r) * LDT + ks * 16 + h * 8];
      KK = MFMA(ak, bk, KK); QK = MFMA(aq, bk, QK);
    }
    const int k = kt * 32 + r;
    const float gck = sgc[k];
#pragma unroll
    for (int i = 0; i < 16; ++i) {
      const int c = ct * 32 + crow(i, h);
      const float dec = (k <= c) ? __expf(sgc[c] - gck) : 0.f;
      sLT[k * 68 + c] = (k < c) ? sbeta[c] * KK[i] * dec : 0.f;
      sAt[c * LDT + k] = f2bf(QK[i] * 0.125f * dec);
    }
  }
  __syncthreads();
#pragma unroll
  for (int q2 = 0; q2 < 2; ++q2) {
    const int q = tid + q2 * 256;
    const int f = q >> 6, ln = q & 63, rp = ln & 31, hp = ln >> 5;
    const int row = (f >> 2) * 32 + rp, k0 = ((f >> 1) & 1) * 32 + (f & 1) * 16 + 4 * hp;
    const u32x2 alo = *(const u32x2*)&sAt[row * LDT + k0], ahi = *(const u32x2*)&sAt[row * LDT + k0 + 8];
    u32x4 oa; oa[0] = alo[0]; oa[1] = alo[1]; oa[2] = ahi[0]; oa[3] = ahi[1];
    *(u32x4*)(UW + 3 * 4096 + q * 8) = oa;
    const u32x2 qlo = *(const u32x2*)&sqb[row * LDT + k0], qhi = *(const u32x2*)&sqb[row * LDT + k0 + 8];
    const float fq = 0.125f * __expf(sgc[row]);
    u32x4 oq;
    oq[0] = pack2(lo_bf(qlo[0]) * fq, hi_bf(qlo[0]) * fq); oq[1] = pack2(lo_bf(qlo[1]) * fq, hi_bf(qlo[1]) * fq);
    oq[2] = pack2(lo_bf(qhi[0]) * fq, hi_bf(qhi[0]) * fq); oq[3] = pack2(lo_bf(qhi[1]) * fq, hi_bf(qhi[1]) * fq);
    *(u32x4*)(UW + 4 * 4096 + q * 8) = oq;
  }
  __syncthreads();
  {
    const int c = tid >> 2, part = tid & 3;
    float* dst = sx + c * 128 + part * 32;
    if (part < 2) {
      const int row = dn_row(b, dir, j, c);
      const bfr* srcp = DQ + (size_t)row * 768 + 512 + hh * 64 + part * 32;
      const float f = sbeta[c];
#pragma unroll
      for (int q = 0; q < 4; ++q) {
        u32x4 v = *(const u32x4*)(srcp + q * 8);
        *(float4*)(dst + q * 8) = make_float4(lo_bf(v[0]) * f, hi_bf(v[0]) * f, lo_bf(v[1]) * f, hi_bf(v[1]) * f);
        *(float4*)(dst + q * 8 + 4) = make_float4(lo_bf(v[2]) * f, hi_bf(v[2]) * f, lo_bf(v[3]) * f, hi_bf(v[3]) * f);
      }
    } else {
      const bfr* srcp = skb + c * LDT + (part - 2) * 32;
      const float f = sbeta[c] * __expf(sgc[c]);
#pragma unroll
      for (int q = 0; q < 4; ++q) {
        u32x4 v = *(const u32x4*)(srcp + q * 8);
        *(float4*)(dst + q * 8) = make_float4(lo_bf(v[0]) * f, hi_bf(v[0]) * f, lo_bf(v[1]) * f, hi_bf(v[1]) * f);
        *(float4*)(dst + q * 8 + 4) = make_float4(lo_bf(v[2]) * f, hi_bf(v[2]) * f, lo_bf(v[3]) * f, hi_bf(v[3]) * f);
      }
    }
  }
  __syncthreads();
  if (tid < 128) {
    const int col = tid;
    for (int rb = 0; rb < 4; ++rb) {
      float acc[16];
#pragma unroll
      for (int i = 0; i < 16; ++i) acc[i] = sx[(rb * 16 + i) * 128 + col];
      for (int k = 0; k < rb * 16; ++k) {
        const float xk = sx[k * 128 + col];
        const float* lp = sLT + k * 68 + rb * 16;
        float4 l0 = *(const float4*)lp, l1 = *(const float4*)(lp + 4), l2 = *(const float4*)(lp + 8), l3 = *(const float4*)(lp + 12);
        acc[0] -= l0.x * xk; acc[1] -= l0.y * xk; acc[2] -= l0.z * xk; acc[3] -= l0.w * xk;
        acc[4] -= l1.x * xk; acc[5] -= l1.y * xk; acc[6] -= l1.z * xk; acc[7] -= l1.w * xk;
        acc[8] -= l2.x * xk; acc[9] -= l2.y * xk; acc[10] -= l2.z * xk; acc[11] -= l2.w * xk;
        acc[12] -= l3.x * xk; acc[13] -= l3.y * xk; acc[14] -= l3.z * xk; acc[15] -= l3.w * xk;
      }
#pragma unroll
      for (int k2 = 0; k2 < 15; ++k2) {
        const float* lp = sLT + (rb * 16 + k2) * 68 + rb * 16;
#pragma unroll
        for (int i = k2 + 1; i < 16; ++i) acc[i] -= lp[i] * acc[k2];
      }
#pragma unroll
      for (int i = 0; i < 16; ++i) sx[(rb * 16 + i) * 128 + col] = acc[i];
    }
  }
  __syncthreads();
  {
    const float gcl = sgc[63];
#pragma unroll
    for (int q2 = 0; q2 < 2; ++q2) {
      const int q = tid + q2 * 256;
      {
        const int f = q >> 6, ln = q & 63, rp = ln & 31, hp = ln >> 5;
        const int row = (f >> 2) * 32 + rp, k0 = ((f >> 1) & 1) * 32 + (f & 1) * 16 + 4 * hp;
        const float4 a = *(const float4*)&sx[row * 128 + 64 + k0], bq = *(const float4*)&sx[row * 128 + 64 + k0 + 8];
        u32x4 ow; ow[0] = pack2(a.x, a.y); ow[1] = pack2(a.z, a.w); ow[2] = pack2(bq.x, bq.y); ow[3] = pack2(bq.z, bq.w);
        *(u32x4*)(UW + 1 * 4096 + q * 8) = ow;
        float kv[8];
#pragma unroll
        for (int jj = 0; jj < 8; ++jj) {
          const int c = k0 + (jj & 3) + 8 * (jj >> 2);
          kv[jj] = bf2f(skb[c * LDT + row]) * __expf(gcl - sgc[c]);
        }
        u32x4 ok; ok[0] = pack2(kv[0], kv[1]); ok[1] = pack2(kv[2], kv[3]); ok[2] = pack2(kv[4], kv[5]); ok[3] = pack2(kv[6], kv[7]);
        *(u32x4*)(UW + 2 * 4096 + q * 8) = ok;
      }
      {
        const int half = q & 1, ln = (q >> 1) & 63, tile = q >> 7, rp = ln & 31, hp = ln >> 5;
        const int ct = tile >> 1, et = tile & 1;
        float uv[8];
#pragma unroll
        for (int ii = 0; ii < 8; ++ii) uv[ii] = sx[(ct * 32 + crow(half * 8 + ii, hp)) * 128 + et * 32 + rp];
        u32x4 ou; ou[0] = pack2(uv[0], uv[1]); ou[1] = pack2(uv[2], uv[3]); ou[2] = pack2(uv[4], uv[5]); ou[3] = pack2(uv[6], uv[7]);
        *(u32x4*)(UW + q * 8) = ou;
      }
    }
    if (tid == 0) ((float*)(p.ws + OFF_GT))[item] = __expf(gcl);
  }
  __syncthreads();
}

template <bool FINAL>
DI void lru_item(const Params& p, int l, int item, char* smem) {
  bfr* xs = (bfr*)smem;
  bfr* sW = xs + 64 * LDT;
  float* segA = (float*)(smem + 5 * 9216);
  float* segH = segA + 1024;
  float* partA = segH + 1024;
  float* partH = partA + 256;
  float* ssp = partH + 256;
  const int tid = opaque(threadIdx.x), lane = tid & 63, w = tid >> 6, r = lane & 31, h = lane >> 5;
  const int tt = w >> 1, et = w & 1, e = et * 32 + r;
  const int kb = item & 3; int rest = item >> 2; const int tb = rest % NCH; const int b = rest / NCH;
  if (FINAL && l == 1 && tb < 4) return;
  const int row0 = (tb < 4) ? MLAT + b * CTX + tb * 64 : b * SEQ + (tb - 4) * 64;
  const int ch = kb * 64 + e;
  {
    const int n = tid >> 2, c0 = (tid & 3) * 16;
    bfr* xrp = (bfr*)(p.ws + R_XR) + (size_t)(row0 + n) * 256 + kb * 64 + c0;
    if (FINAL) {
      *(u32x4*)&xs[n * LDT + c0] = *(const u32x4*)xrp; *(u32x4*)&xs[n * LDT + c0 + 8] = *(const u32x4*)(xrp + 8);
    } else {
      const int t = ((tb < 4) ? tb * 64 : (tb - 4) * 64) + n, L = (tb < 4) ? CTX : SEQ;
      const bfr* P = (const bfr*)(p.ws + R_P);
      const float* cw = p.in[I_LCW] + (size_t)l * 1024 + kb * 64 + c0;
      float a[16];
      {
        const float* cb = p.in[I_LCB] + l * 256 + kb * 64 + c0;
#pragma unroll
        for (int q = 0; q < 4; ++q) { const float4 bv = *(const float4*)(cb + q * 4); a[q * 4] = bv.x; a[q * 4 + 1] = bv.y; a[q * 4 + 2] = bv.z; a[q * 4 + 3] = bv.w; }
      }
#pragma unroll
      for (int tap = 0; tap < 4; ++tap) {
        const int tt = t - 1 + tap;
        if (tt >= 0 && tt < L) {
          const bfr* xp = P + (size_t)(row0 + n - 1 + tap) * PC + kb * 64 + c0;
          const u32x4 x0 = *(const u32x4*)xp, x1 = *(const u32x4*)(xp + 8);
#pragma unroll
          for (int q = 0; q < 4; ++q) {
            const float4 wv = *(const float4*)(cw + tap * 256 + q * 4);
            const unsigned ua = (q < 2) ? x0[q * 2] : x1[(q - 2) * 2], ub = (q < 2) ? x0[q * 2 + 1] : x1[(q - 2) * 2 + 1];
            a[q * 4] += wv.x * lo_bf(ua); a[q * 4 + 1] += wv.y * hi_bf(ua); a[q * 4 + 2] += wv.z * lo_bf(ub); a[q * 4 + 3] += wv.w * hi_bf(ub);
          }
        }
      }
      u32x4 o0, o1;
#pragma unroll
      for (int q = 0; q < 4; ++q) { o0[q] = pack2(a[2 * q], a[2 * q + 1]); o1[q] = pack2(a[8 + 2 * q], a[8 + 2 * q + 1]); }
      *(u32x4*)&xs[n * LDT + c0] = o0; *(u32x4*)&xs[n * LDT + c0 + 8] = o1;
      *(u32x4*)xrp = o0; *(u32x4*)(xrp + 8) = o1;
    }
#pragma unroll
    for (int m = 0; m < 4; ++m) {
      const bfr* wsrc = (const bfr*)(p.ws + OFF_WL) + ((size_t)((l * 2 + (m >> 1)) * 2 + (m & 1)) * 4 + kb) * 4096 + n * 64 + c0;
      *(u32x4*)&sW[(m * 64 + n) * LDT + c0] = *(const u32x4*)wsrc; *(u32x4*)&sW[(m * 64 + n) * LDT + c0 + 8] = *(const u32x4*)(wsrc + 8);
    }
  }
  __syncthreads();
  float y[16];
#pragma unroll
  for (int i = 0; i < 16; ++i) y[i] = 0.f;
  float* carry = (float*)(p.ws + OFF_CAR);
#pragma unroll
  for (int dir = 0; dir < 2; ++dir) {
    f32x16 zr, zi;
#pragma unroll
    for (int i = 0; i < 16; ++i) { zr[i] = 0.f; zi[i] = 0.f; }
#pragma unroll
    for (int ks = 0; ks < 4; ++ks) {
      const bf16x8 af = *(const bf16x8*)&xs[(tt * 32 + r) * LDT + ks * 16 + h * 8];
      const bf16x8 wr = *(const bf16x8*)&sW[((dir * 2 + 0) * 64 + e) * LDT + ks * 16 + h * 8];
      const bf16x8 wi = *(const bf16x8*)&sW[((dir * 2 + 1) * 64 + e) * LDT + ks * 16 + h * 8];
      zr = MFMA(af, wr, zr); zi = MFMA(af, wi, zi);
    }
    const float br = p.in[I_LBR][(l * 2 + dir) * 256 + ch], bi = p.in[I_LBI][(l * 2 + dir) * 256 + ch];
    const float sp = softplusf_(-p.in[I_LLAM][(l * 2 + dir) * 256 + ch]);
    float a[16], u[16];
#pragma unroll
    for (int i = 0; i < 16; ++i) {
      const float rg = sigmoidf_(zr[i] + br), ig = sigmoidf_(zi[i] + bi);
      const float la = -8.f * rg * sp;
      a[i] = __expf(la);
      const float mult = __builtin_amdgcn_sqrtf(fmaxf(1.f - a[i] * a[i], 0.f));
      u[i] = mult * ig * bf2f(xs[(tt * 32 + crow(i, h)) * LDT + e]);
    }
#pragma unroll
    for (int g = 0; g < 4; ++g) {
      float A = 1.f, H = 0.f;
      if (dir == 0) {
#pragma unroll
        for (int i = 4 * g; i < 4 * g + 4; ++i) { H = a[i] * H + u[i]; A *= a[i]; }
      } else {
#pragma unroll
        for (int i = 4 * g + 3; i >= 4 * g; --i) { H = a[i] * H + u[i]; A *= a[i]; }
      }
      segA[(tt * 8 + 2 * g + h) * 64 + e] = A; segH[(tt * 8 + 2 * g + h) * 64 + e] = H;
    }
    const int j = (tb < 4) ? (dir ? 3 - tb : tb) : (dir ? 4 + 127 - (tb - 4) : tb);
    float hin = 0.f;
    if (FINAL) hin = ((const float*)(p.ws + OFF_HIN))[((size_t)(b * 2 + dir) * NCH + j) * 256 + ch];
    __syncthreads();
    if (!FINAL) {
      if (tid < 64) {
        float At = 1.f, Ht = 0.f;
#pragma unroll
        for (int s = 0; s < 16; ++s) {
          const int sg = dir ? 15 - s : s;
          Ht = segA[sg * 64 + tid] * Ht + segH[sg * 64 + tid]; At *= segA[sg * 64 + tid];
        }
        *(float2*)(carry + ((size_t)(b * 2 + dir) * NCH + j) * 512 + (kb * 64 + tid) * 2) = make_float2(At, Ht);
      }
    } else {
      float st = hin;
      float start[4] = {0.f, 0.f, 0.f, 0.f};
#pragma unroll
      for (int s = 0; s < 16; ++s) {
        const int sg = dir ? 15 - s : s;
        const bool mine = ((sg >> 3) == tt) && ((sg & 1) == h);
        start[(sg >> 1) & 3] = mine ? st : start[(sg >> 1) & 3];
        st = segA[sg * 64 + e] * st + segH[sg * 64 + e];
      }
#pragma unroll
      for (int g = 0; g < 4; ++g) {
        float hs = start[g];
        if (dir == 0) {
#pragma unroll
          for (int i = 4 * g; i < 4 * g + 4; ++i) { hs = a[i] * hs + u[i]; y[i] += hs; }
        } else {
#pragma unroll
          for (int i = 4 * g + 3; i >= 4 * g; --i) { hs = a[i] * hs + u[i]; y[i] += hs; }
        }
      }
    }
    __syncthreads();
  }
  if (FINAL) {
    const bfr* GZ = (const bfr*)(p.ws + R_GZ);
    bfr* Y = (bfr*)(p.ws + R_YREST);
    const float gg = p.in[I_GGRP][l * 768 + 512 + ch];
#pragma unroll
    for (int i = 0; i < 16; ++i) {
      const int n = tt * 32 + crow(i, h);
      const size_t row = (size_t)(row0 + n);
      const float o = bf2f(GZ[row * 512 + ch]) * y[i];
      float ss = o * o;
      ss += __shfl_xor(ss, 1); ss += __shfl_xor(ss, 2); ss += __shfl_xor(ss, 4); ss += __shfl_xor(ss, 8); ss += __shfl_xor(ss, 16);
      if (r == 0) ssp[et * 64 + n] = ss;
      Y[row * 512 + ch] = f2bf(o * gg);
    }
    __syncthreads();
    if (tid < 64) ((float*)(p.ws + OFF_SSL))[(size_t)(row0 + tid) * 4 + kb] = ssp[tid] + ssp[64 + tid];
  }
  __syncthreads();
}

DI void lru_prefix_item(const Params& p, int item) {
  const int tid = opaque(threadIdx.x);
  const float* cb = (const float*)(p.ws + OFF_CAR) + (size_t)item * NCH * 512 + tid * 2;
  float* hin = (float*)(p.ws + OFF_HIN) + (size_t)item * NCH * 256 + tid;
  float st = 0.f;
  for (int j0 = 0; j0 < NCH; j0 += 33) {
    float2 cv[33];
#pragma unroll
    for (int q = 0; q < 33; ++q) cv[q] = *(const float2*)(cb + (size_t)(j0 + q) * 512);
#pragma unroll
    for (int q = 0; q < 33; ++q) { hin[(size_t)(j0 + q) * 256] = st; st = cv[q].x * st + cv[q].y; }
  }
}

DI void unpack_u(const u32x4& a, const u32x4& b, float* o) {
#pragma unroll
  for (int i = 0; i < 4; ++i) { o[2 * i] = lo_bf(a[i]); o[2 * i + 1] = hi_bf(a[i]); o[8 + 2 * i] = lo_bf(b[i]); o[8 + 2 * i + 1] = hi_bf(b[i]); }
}

DI void dn_chain_item(const Params& p, int item) {
  const int tid = opaque(threadIdx.x), lane = tid & 63, w = tid >> 6;
  if (w < 2) {
    const int et = w;
    const bfr* UW = (const bfr*)(p.ws + R_UWA) + (size_t)item * NCH * 5 * 4096;
    const float* GT = (const float*)(p.ws + OFF_GT) + (size_t)item * NCH;
    bfr* SJ = (bfr*)(p.ws + R_SJ) + ((size_t)item * NCH * 2 + et) * 2048;
    f32x16 S[2];
#pragma unroll
    for (int i = 0; i < 16; ++i) { S[0][i] = 0.f; S[1][i] = 0.f; }
    bf16x8 nw[8], nk[8]; u32x4 nu[4]; float ngt;
    {
      const bfr* m = UW;
#pragma unroll
      for (int f = 0; f < 8; ++f) { nw[f] = *(const bf16x8*)(m + 4096 + (f * 64 + lane) * 8); nk[f] = *(const bf16x8*)(m + 8192 + (f * 64 + lane) * 8); }
#pragma unroll
      for (int ct = 0; ct < 2; ++ct) { const bfr* up = m + ((ct * 2 + et) * 64 + lane) * 16; nu[ct * 2] = *(const u32x4*)up; nu[ct * 2 + 1] = *(const u32x4*)(up + 8); }
      ngt = GT[0];
    }
    for (int j = 0; j < NCH; ++j) {
      bf16x8 cw[8], ck[8]; u32x4 cu[4];
#pragma unroll
      for (int f = 0; f < 8; ++f) { cw[f] = nw[f]; ck[f] = nk[f]; }
#pragma unroll
      for (int f = 0; f < 4; ++f) cu[f] = nu[f];
      const float gt = ngt;
      if (j + 1 < NCH) {
        const bfr* m = UW + (size_t)(j + 1) * 5 * 4096;
#pragma unroll
        for (int f = 0; f < 8; ++f) { nw[f] = *(const bf16x8*)(m + 4096 + (f * 64 + lane) * 8); nk[f] = *(const bf16x8*)(m + 8192 + (f * 64 + lane) * 8); }
#pragma unroll
        for (int ct = 0; ct < 2; ++ct) { const bfr* up = m + ((ct * 2 + et) * 64 + lane) * 16; nu[ct * 2] = *(const u32x4*)up; nu[ct * 2 + 1] = *(const u32x4*)(up + 8); }
        ngt = GT[j + 1];
      }
      bf16x8 Sb[2][2];
#pragma unroll
      for (int dt = 0; dt < 2; ++dt)
#pragma unroll
        for (int s = 0; s < 2; ++s) {
          Sb[dt][s] = pack_step(S[dt], s);
          *(bf16x8*)(SJ + (size_t)j * 4096 + ((dt * 2 + s) * 64 + lane) * 8) = Sb[dt][s];
        }
      f32x16 WS[2];
#pragma unroll
      for (int ct = 0; ct < 2; ++ct) {
#pragma unroll
        for (int i = 0; i < 16; ++i) WS[ct][i] = 0.f;
#pragma unroll
        for (int dt = 0; dt < 2; ++dt)
#pragma unroll
          for (int s = 0; s < 2; ++s) WS[ct] = MFMA(cw[(ct * 2 + dt) * 2 + s], Sb[dt][s], WS[ct]);
      }
      bf16x8 Vb[2][2];
#pragma unroll
      for (int ct = 0; ct < 2; ++ct) {
        float uf[16];
        unpack_u(cu[ct * 2], cu[ct * 2 + 1], uf);
        f32x16 vn;
#pragma unroll
        for (int i = 0; i < 16; ++i) vn[i] = uf[i] - WS[ct][i];
        Vb[ct][0] = pack_step(vn, 0); Vb[ct][1] = pack_step(vn, 1);
      }
#pragma unroll
      for (int i = 0; i < 16; ++i) { S[0][i] *= gt; S[1][i] *= gt; }
#pragma unroll
      for (int dt = 0; dt < 2; ++dt)
#pragma unroll
        for (int ct = 0; ct < 2; ++ct)
#pragma unroll
          for (int s = 0; s < 2; ++s) S[dt] = MFMA(ck[(dt * 2 + ct) * 2 + s], Vb[ct][s], S[dt]);
    }
  }
  __syncthreads();
}

DI void dn_out_item(const Params& p, int l, int item, char* smem) {
  float* so = (float*)smem;
  const int tid = opaque(threadIdx.x), lane = tid & 63, w = tid >> 6, r = lane & 31, h = lane >> 5;
  const int tb = item % NCH; const int bh = item / NCH; const int hh = bh & 3, b = bh >> 2;
  if (l == 1 && tb < 4) return;
  const int dir = w >> 1, et = w & 1;
  const int j = dir ? (tb < 4 ? 3 - tb : 4 + 127 - (tb - 4)) : tb;
  const size_t idx = (size_t)((b * 4 + hh) * 2 + dir) * NCH + j;
  const bfr* m = (const bfr*)(p.ws + R_UWA) + idx * 5 * 4096;
  const bfr* SJ = (const bfr*)(p.ws + R_SJ) + (idx * 2 + et) * 2048;
  bf16x8 Sb[2][2];
#pragma unroll
  for (int dt = 0; dt < 2; ++dt)
#pragma unroll
    for (int s = 0; s < 2; ++s) Sb[dt][s] = *(const bf16x8*)(SJ + ((dt * 2 + s) * 64 + lane) * 8);
  f32x16 WS[2], O[2];
#pragma unroll
  for (int ct = 0; ct < 2; ++ct) {
#pragma unroll
    for (int i = 0; i < 16; ++i) { WS[ct][i] = 0.f; O[ct][i] = 0.f; }
#pragma unroll
    for (int dt = 0; dt < 2; ++dt)
#pragma unroll
      for (int s = 0; s < 2; ++s) {
        const int f = (ct * 2 + dt) * 2 + s;
        const bf16x8 wf = *(const bf16x8*)(m + 4096 + (f * 64 + lane) * 8);
        const bf16x8 qf = *(const bf16x8*)(m + 4 * 4096 + (f * 64 + lane) * 8);
        WS[ct] = MFMA(wf, Sb[dt][s], WS[ct]);
        O[ct] = MFMA(qf, Sb[dt][s], O[ct]);
      }
  }
  bf16x8 Vb[2][2];
#pragma unroll
  for (int ct = 0; ct < 2; ++ct) {
    const bfr* up = m + ((ct * 2 + et) * 64 + lane) * 16;
    const u32x4 u0 = *(const u32x4*)up, u1 = *(const u32x4*)(up + 8);
    float uf[16];
    unpack_u(u0, u1, uf);
    f32x16 vn;
#pragma unroll
    for (int i = 0; i < 16; ++i) vn[i] = uf[i] - WS[ct][i];
    Vb[ct][0] = pack_step(vn, 0); Vb[ct][1] = pack_step(vn, 1);
  }
#pragma unroll
  for (int ct = 0; ct < 2; ++ct)
#pragma unroll
    for (int c2 = 0; c2 < 2; ++c2)
#pragma unroll
      for (int s = 0; s < 2; ++s) {
        const int f = (ct * 2 + c2) * 2 + s;
        const bf16x8 af = *(const bf16x8*)(m + 3 * 4096 + (f * 64 + lane) * 8);
        O[ct] = MFMA(af, Vb[c2][s], O[ct]);
      }
  if (dir == 0) {
#pragma unroll
    for (int ct = 0; ct < 2; ++ct)
#pragma unroll
      for (int i = 0; i < 16; ++i) so[(ct * 32 + crow(i, h)) * 65 + et * 32 + r] = O[ct][i];
  }
  __syncthreads();
  if (dir == 1) {
#pragma unroll
    for (int ct = 0; ct < 2; ++ct)
#pragma unroll
      for (int i = 0; i < 16; ++i) so[(63 - (ct * 32 + crow(i, h))) * 65 + et * 32 + r] += O[ct][i];
  }
  __syncthreads();
  {
    const int n = tid >> 2, e0 = (tid & 3) * 16;
    const int row = ((tb < 4) ? MLAT + b * CTX + tb * 64 : b * SEQ + (tb - 4) * 64) + n;
    float v[16]; float ss = 0.f;
#pragma unroll
    for (int i = 0; i < 16; ++i) { v[i] = so[n * 65 + e0 + i]; ss += v[i] * v[i]; }
    ss += __shfl_xor(ss, 1); ss += __shfl_xor(ss, 2);
    const float rs = rsqrtf(ss * (1.f / 64.f) + EPS);
    const bfr* gz = (const bfr*)(p.ws + R_GZ) + (size_t)row * 512 + 256 + hh * 64 + e0;
    const u32x4 z0 = *(const u32x4*)gz, z1 = *(const u32x4*)(gz + 8);
    float zf[16]; unpack_u(z0, z1, zf);
    const float* gd = p.in[I_GDN] + l * 64 + e0;
    u32x4 o0, o1;
#pragma unroll
    for (int i = 0; i < 4; ++i) {
      o0[i] = pack2(v[2 * i] * rs * gd[2 * i] * zf[2 * i], v[2 * i + 1] * rs * gd[2 * i + 1] * zf[2 * i + 1]);
      o1[i] = pack2(v[8 + 2 * i] * rs * gd[8 + 2 * i] * zf[8 + 2 * i], v[8 + 2 * i + 1] * rs * gd[8 + 2 * i + 1] * zf[8 + 2 * i + 1]);
    }
    bfr* y = (bfr*)(p.ws + R_YREST) + (size_t)row * 512 + 256 + hh * 64 + e0;
    *(u32x4*)y = o0; *(u32x4*)(y + 8) = o1;
  }
  __syncthreads();
}

DI void attn_item(const Params& p, int l, const bfr* __restrict__ Qp, const bfr* __restrict__ Kp0, const bfr* __restrict__ Vtp0, int kbeg, int nkeys, int out_row0, int head, int part, char* smem) {
  const bfr* Kp = Kp0 + (size_t)kbeg * 64;
  const bfr* Vtp = Vtp0 + kbeg;
  constexpr int LDV = 136;
  bfr* sK = (bfr*)smem;
  bfr* sV = sK + 128 * LDT;
  const int tid = opaque(threadIdx.x), lane = tid & 63, w = tid >> 6, r = lane & 31, h = lane >> 5;
  bf16x8 qf[4];
#pragma unroll
  for (int ks = 0; ks < 4; ++ks) qf[ks] = *(const bf16x8*)(Qp + (size_t)(w * 32 + r) * 64 + ks * 16 + h * 8);
  f32x16 O[2];
#pragma unroll
  for (int i = 0; i < 16; ++i) { O[0][i] = 0.f; O[1][i] = 0.f; }
  float m = -1e30f, lsum = 0.f;
  const int kr = tid >> 1, kc = (tid & 1) * 32;
  const int vr = tid >> 2, vc = (tid & 3) * 32;
  const bfr* gk = Kp + (size_t)kr * 64 + kc;
  const bfr* gv = Vtp + (size_t)vr * LK + vc;
  u32x4 rk[4], rv[4];
#pragma unroll
  for (int i = 0; i < 4; ++i) { rk[i] = *(const u32x4*)(gk + i * 8); rv[i] = *(const u32x4*)(gv + i * 8); }
  for (int kb = 0; kb < nkeys; kb += 128) {
    __syncthreads();
#pragma unroll
    for (int i = 0; i < 4; ++i) { *(u32x4*)&sK[kr * LDT + kc + i * 8] = rk[i]; *(u32x4*)&sV[vr * LDV + vc + i * 8] = rv[i]; }
    __syncthreads();
    if (kb + 128 < nkeys) {
      const bfr* gk2 = gk + (size_t)(kb + 128) * 64; const bfr* gv2 = gv + (kb + 128);
#pragma unroll
      for (int i = 0; i < 4; ++i) { rk[i] = *(const u32x4*)(gk2 + i * 8); rv[i] = *(const u32x4*)(gv2 + i * 8); }
    }
    f32x16 st[4];
    __builtin_amdgcn_s_setprio(1);
#pragma unroll
    for (int t2 = 0; t2 < 4; ++t2) {
#pragma unroll
      for (int i = 0; i < 16; ++i) st[t2][i] = 0.f;
#pragma unroll
      for (int ks = 0; ks < 4; ++ks) {
        bf16x8 kf = *(const bf16x8*)&sK[(t2 * 32 + r) * LDT + ks * 16 + h * 8];
        st[t2] = MFMA(kf, qf[ks], st[t2]);
      }
    }
    __builtin_amdgcn_s_setprio(0);
    float mx = st[0][0];
#pragma unroll
    for (int t2 = 0; t2 < 4; ++t2)
#pragma unroll
      for (int i = 0; i < 16; ++i) mx = fmaxf(mx, st[t2][i]);
    mx = fmaxf(mx, __shfl_xor(mx, 32));
    const float mnew = fmaxf(m, mx);
    const float alpha = __builtin_amdgcn_exp2f(m - mnew);
    m = mnew;
    float ps = 0.f;
#pragma unroll
    for (int t2 = 0; t2 < 4; ++t2)
#pragma unroll
      for (int i = 0; i < 16; ++i) { float pv = __builtin_amdgcn_exp2f(st[t2][i] - mnew); st[t2][i] = pv; ps += pv; }
    lsum = lsum * alpha + ps;
#pragma unroll
    for (int i = 0; i < 16; ++i) { O[0][i] *= alpha; O[1][i] *= alpha; }
    __builtin_amdgcn_s_setprio(1);
#pragma unroll
    for (int t2 = 0; t2 < 4; ++t2)
#pragma unroll
      for (int s = 0; s < 2; ++s) {
        bf16x8 pb = pack_step(st[t2], s);
#pragma unroll
        for (int dt = 0; dt < 2; ++dt) {
          bf16x8 vf = *(const bf16x8*)&sV[(dt * 32 + r) * LDV + t2 * 32 + s * 16 + h * 8];
          O[dt] = MFMA(vf, pb, O[dt]);
        }
      }
    __builtin_amdgcn_s_setprio(0);
  }
  lsum += __shfl_xor(lsum, 32);
  if (part >= 0) {
    float* po = (float*)(p.ws + R_PO) + ((size_t)part * 128 + w * 32 + r) * 64;
#pragma unroll
    for (int dt = 0; dt < 2; ++dt)
#pragma unroll
      for (int g = 0; g < 4; ++g)
        *(float4*)(po + dt * 32 + 8 * g + 4 * h) = make_float4(O[dt][4 * g], O[dt][4 * g + 1], O[dt][4 * g + 2], O[dt][4 * g + 3]);
    if (h == 0) ((float2*)(p.ws + OFF_ML))[(size_t)part * 128 + w * 32 + r] = make_float2(m, lsum);
    __syncthreads();
    return;
  }
  const float inv = 1.f / lsum;
  float ss = 0.f;
#pragma unroll
  for (int dt = 0; dt < 2; ++dt)
#pragma unroll
    for (int i = 0; i < 16; ++i) { O[dt][i] *= inv; ss += O[dt][i] * O[dt][i]; }
  ss += __shfl_xor(ss, 32);
  const int row = out_row0 + w * 32 + r;
  if (h == 0) ((float*)(p.ws + OFF_SSA))[(size_t)row * 8 + head] = ss;
  const float* gg = p.in[I_GGRP] + l * 768 + head * 64;
  bfr* Y = (bfr*)(p.ws + R_YATT) + (size_t)row * 512 + head * 64;
#pragma unroll
  for (int dt = 0; dt < 2; ++dt)
#pragma unroll
    for (int g = 0; g < 4; ++g) {
      const int d0 = dt * 32 + 8 * g + 4 * h;
      u32x2 o;
      o[0] = pack2(O[dt][4 * g + 0] * gg[d0 + 0], O[dt][4 * g + 1] * gg[d0 + 1]);
      o[1] = pack2(O[dt][4 * g + 2] * gg[d0 + 2], O[dt][4 * g + 3] * gg[d0 + 3]);
      *(u32x2*)(Y + d0) = o;
    }
  __syncthreads();
}


DI void attn_merge_item(const Params& p, int l, int sidx) {
  const int tid = opaque(threadIdx.x);
  const int a = N_ATT_FULL + sidx;
  const int qb = a >> 4, bh = a & 15, b = bh >> 3, hd = bh & 7;
  const int rowl = tid >> 1, half = tid & 1;
  const float2* ML = (const float2*)(p.ws + OFF_ML);
  const float* PO = (const float*)(p.ws + R_PO);
  float2 ml[4]; float M = -1e30f;
#pragma unroll
  for (int kq = 0; kq < 4; ++kq) { ml[kq] = ML[(size_t)(sidx * 4 + kq) * 128 + rowl]; M = fmaxf(M, ml[kq].x); }
  float wgt[4], L = 0.f;
#pragma unroll
  for (int kq = 0; kq < 4; ++kq) { wgt[kq] = __builtin_amdgcn_exp2f(ml[kq].x - M); L += ml[kq].y * wgt[kq]; }
  const float inv = 1.f / L;
  float o[32];
#pragma unroll
  for (int i = 0; i < 32; ++i) o[i] = 0.f;
#pragma unroll
  for (int kq = 0; kq < 4; ++kq) {
    const float* src = PO + ((size_t)(sidx * 4 + kq) * 128 + rowl) * 64 + half * 32;
#pragma unroll
    for (int q = 0; q < 8; ++q) {
      const float4 v = *(const float4*)(src + q * 4);
      o[q * 4] += v.x * wgt[kq]; o[q * 4 + 1] += v.y * wgt[kq]; o[q * 4 + 2] += v.z * wgt[kq]; o[q * 4 + 3] += v.w * wgt[kq];
    }
  }
  float ss = 0.f;
#pragma unroll
  for (int i = 0; i < 32; ++i) { o[i] *= inv; ss += o[i] * o[i]; }
  ss += __shfl_xor(ss, 1);
  const size_t row = (size_t)b * SEQ + qb * 128 + rowl;
  if (half == 0) ((float*)(p.ws + OFF_SSA))[row * 8 + hd] = ss;
  const float* gg = p.in[I_GGRP] + l * 768 + hd * 64 + half * 32;
  bfr* Y = (bfr*)(p.ws + R_YATT) + row * 512 + hd * 64 + half * 32;
#pragma unroll
  for (int q = 0; q < 4; ++q) {
    u32x4 ov;
#pragma unroll
    for (int k = 0; k < 4; ++k) ov[k] = pack2(o[q * 8 + 2 * k] * gg[q * 8 + 2 * k], o[q * 8 + 2 * k + 1] * gg[q * 8 + 2 * k + 1]);
    *(u32x4*)(Y + q * 8) = ov;
  }
}

#define XB_TMO      128
#define XB_XCNT(j)  (256  + 64 * (j))
#define XB_XSUB(j)  (1280 + 64 * (j))
#define XB_XGEN(j)  (2304 + 64 * (j))
#define XB_TOP      3328
#define XB_TOPGEN   3392
#define XCD_BAR_WORDS 3456
#define XB_SPIN_CAP (1u << 22)
#define LAS __attribute__((address_space(3)))
DI unsigned xb_ld(unsigned* p) { return __hip_atomic_load(p, __ATOMIC_RELAXED, __HIP_MEMORY_SCOPE_AGENT); }
DI unsigned xb_add(unsigned* p, unsigned v) { return __hip_atomic_fetch_add(p, v, __ATOMIC_RELAXED, __HIP_MEMORY_SCOPE_AGENT); }
DI unsigned xb_xcc_id() { return (unsigned)__builtin_amdgcn_s_getreg((3 << 11) | 20) & 0xFu; }
#define XB_SPIN(cond, bar) do { unsigned _sp = 0; while (cond) { __builtin_amdgcn_s_sleep(1); \
    if ((++_sp & 255u) == 0u) { if (xb_ld(&(bar)[XB_TMO])) break; if (_sp > XB_SPIN_CAP) { atomicAdd(&(bar)[XB_TMO], 1u); break; } } } } while (0)
struct XcdBarrier { unsigned* bar; unsigned x; volatile LAS unsigned* st; };
DI XcdBarrier xcd_barrier_post(unsigned* bar, volatile LAS unsigned* st) {
  XcdBarrier b; b.bar = bar; b.x = xb_xcc_id(); b.st = st;
  if (threadIdx.x == 0) (void)xb_add(&bar[XB_XCNT(b.x)], 1u);
  return b;
}
DI void xcd_barrier_complete(unsigned* bar, unsigned x, unsigned& nloc, unsigned& nx) {
  const unsigned G = gridDim.x * gridDim.y * gridDim.z;
  unsigned sum, cnt, mine, sp = 0u;
  for (;;) {
    sum = 0u; cnt = 0u; mine = 0u;
#pragma unroll
    for (unsigned j = 0; j < 16; ++j) { const unsigned c = xb_ld(&bar[XB_XCNT(j)]); sum += c; cnt += (c > 0u) ? 1u : 0u; mine = (j == x) ? c : mine; }
    if (sum == G) break;
    __builtin_amdgcn_s_sleep(1);
    if ((++sp & 255u) == 0u) { if (xb_ld(&bar[XB_TMO])) break; if (sp > XB_SPIN_CAP) { atomicAdd(&bar[XB_TMO], 1u); break; } }
  }
  nloc = mine > 0u ? mine : 1u; nx = cnt > 0u ? cnt : 1u;
}
DI void xcd_barrier(const XcdBarrier& b) {
  asm volatile("s_waitcnt vmcnt(0)" ::: "memory");
  __syncthreads();
  if (threadIdx.x == 0) {
    unsigned* bar = b.bar;
    __builtin_amdgcn_s_waitcnt(0);
    unsigned nloc = b.st[0], nx = b.st[1];
    if (nloc == 0u) { xcd_barrier_complete(bar, b.x, nloc, nx); b.st[0] = nloc; b.st[1] = nx; }
    const unsigned old = xb_add(&bar[XB_XSUB(b.x)], 1u);
    const unsigned gen = old / nloc;
    if (old + 1u == (gen + 1u) * nloc) {
      __builtin_amdgcn_fence(__ATOMIC_RELEASE, "agent");
      asm volatile("s_waitcnt vmcnt(0)" ::: "memory");
      const unsigned og = xb_add(&bar[XB_TOP], 1u);
      const unsigned tg = og / nx;
      if (og + 1u == (tg + 1u) * nx) xb_add(&bar[XB_TOPGEN], 1u);
      else XB_SPIN(xb_ld(&bar[XB_TOPGEN]) == tg, bar);
      __builtin_amdgcn_fence(__ATOMIC_ACQUIRE, "agent");
      xb_add(&bar[XB_XGEN(b.x)], 1u);
      asm volatile("s_waitcnt vmcnt(0)" ::: "memory");
    } else {
      XB_SPIN(xb_ld(&bar[XB_XGEN(b.x)]) == gen, bar);
      __builtin_amdgcn_fence(__ATOMIC_ACQUIRE, "agent");
      asm volatile("s_waitcnt vmcnt(0)" ::: "memory");
    }
  }
  __syncthreads();
}

constexpr int SMEM_BYTES = 60 * 1024;

__global__ void __launch_bounds__(256, 2) mega(Params p) {
  cg::grid_group grid = cg::this_grid();
  __shared__ __attribute__((aligned(16))) char smem[SMEM_BYTES];
  __shared__ int s_item;
  const int tid = opaque(threadIdx.x), lane = tid & 63, w = tid >> 6;
  const int G = gridDim.x, bid = blockIdx.x;
  int* cnt = (int*)(p.ws + OFF_CNT);
  unsigned* bar = (unsigned*)(p.ws + OFF_BAR);
  __shared__ uint4 xb_words;
  if (tid == 0) xb_words = make_uint4(0u, 0u, 0u, 0u);

  __syncthreads();
  XcdBarrier xb = xcd_barrier_post(bar, (volatile LAS unsigned*)&xb_words);
  if (p.out == nullptr) grid.sync();
  for (int it = bid; it < N_WCONV + N_MOD + N_ROPE + N_WL; it += G) phase0_item(p, (it < N_MOD + N_ROPE + N_WL) ? N_WCONV + it : it - (N_MOD + N_ROPE + N_WL), smem);
  xcd_barrier(xb);
  for (int rb = bid; rb < MTOT / 8; rb += G) rownorm_phase(p, 0, 0, rb);
  xcd_barrier(xb);

  for (int l = 0; l < 2; ++l) {
    const int mt_rows = (l == 0) ? MTOT : MLAT;
    {
      const bfr* A = (const bfr*)(p.ws + R_H);
      const bfr* Wt = (const bfr*)(p.ws + OFF_WIN) + (size_t)l * INP * D;
      for (int rep = 0; rep < REP_GEMM; ++rep) gemm_phase<EPI_IN, 4>(p, l, A, D, nullptr, Wt, D, INP / 128, MTOT, nullptr, 0, smem);
    }
    xcd_barrier(xb);
    {
      const int n1 = 2 * NCH * 4, n2 = MTOT / 16;
      for (int it = bid; it < n1 + n2; it += G) {
        if (it < n1) lru_item<false>(p, l, it, smem); else conv_item(p, l, it - n1);
      }
    }
    xcd_barrier(xb);
    {
      const int n1 = 16 * NCH;
      for (int it = bid; it < n1 + 4; it += G) {
        if (it < 4) lru_prefix_item(p, it); else dn_prep_item(p, it - 4, smem);
      }
    }
    xcd_barrier(xb);
    {
      const int n_scan = 16, n_full = N_ATT_FULL, n_part = N_ATT_SPLIT * 4, n_catt = (l == 0) ? 2 * 8 * 2 : 0;
      const int ntot = n_scan + n_full + n_part + n_catt;
      for (;;) {
        if (tid == 0) s_item = atomicAdd(&cnt[l], 1);
        __syncthreads();
        const int it = s_item;
        __syncthreads();
        if (it >= ntot) break;
        if (it < n_scan) dn_chain_item(p, it);
        else if (it < n_scan + n_full + n_part) {
          int a, part = -1, kbeg = 0, nkeys = LK;
          if (it < n_scan + n_full) a = it - n_scan;
          else { const int q = it - n_scan - n_full; a = N_ATT_FULL + (q >> 2); part = q; kbeg = (q & 3) * 2112 - (q & 1) * 64; nkeys = 2048 + (q & 1) * 128; }
          const int qb = a >> 4, bh = a & 15, b = bh >> 3, hd = bh & 7;
          const bfr* Qp = (const bfr*)(p.ws + R_Q) + ((size_t)(b * 8 + hd) * SEQ + qb * 128) * 64;
          const bfr* Kp = (const bfr*)(p.ws + R_K) + (size_t)(b * 2 + (hd >> 2)) * LK * 64;
          const bfr* Vp = (const bfr*)(p.ws + R_VT) + (size_t)(b * 2 + (hd >> 2)) * 64 * LK;
          attn_item(p, l, Qp, Kp, Vp, kbeg, nkeys, b * SEQ + qb * 128, hd, part, smem);
        } else {
          const int a = it - n_scan - n_full - n_part;
          const int qb = a & 1, bh = a >> 1, b = bh >> 3, hd = bh & 7;
          const bfr* Qp = (const bfr*)(p.ws + R_Q) + (size_t)MLAT * 512 + ((size_t)(b * 8 + hd) * CTX + qb * 128) * 64;
          const bfr* Kp = (const bfr*)(p.ws + R_K) + (size_t)(b * 2 + (hd >> 2)) * LK * 64;
          const bfr* Vp = (const bfr*)(p.ws + R_VT) + (size_t)(b * 2 + (hd >> 2)) * 64 * LK;
          attn_item(p, l, Qp, Kp, Vp, 0, CTX, MLAT + b * CTX + qb * 128, hd, -1, smem);
        }
      }
    }
    xcd_barrier(xb);
    {
      const int n1 = 2 * NCH * 4, n2 = 8 * NCH, n3 = N_ATT_SPLIT;
      for (;;) {
        if (tid == 0) s_item = atomicAdd(&cnt[6 + l], 1);
        __syncthreads();
        const int it = s_item;
        __syncthreads();
        if (it >= n1 + n2 + n3) break;
        if (it < n1) lru_item<true>(p, l, it, smem);
        else if (it < n1 + n2) dn_out_item(p, l, it - n1, smem);
        else attn_merge_item(p, l, it - n1 - n2);
      }
    }
    xcd_barrier(xb);
    {
      const bfr* A = (const bfr*)(p.ws + R_YATT);
      const bfr* A2 = (const bfr*)(p.ws + R_YREST);
      const bfr* Wt = (const bfr*)(p.ws + OFF_WOUT) + (size_t)l * D * D;
      for (int rep = 0; rep < REP_GEMM; ++rep) gemm_phase<EPI_OUTPROJ, 2>(p, l, A, 512, A2, Wt, D, D / 128, mt_rows, (float*)(p.ws + R_MIX), D, smem);
    }
    xcd_barrier(xb);
    for (int rep = 0; rep < REP_NORM; ++rep) for (int rb = bid; rb < mt_rows / 8; rb += G) rownorm_phase(p, l, 1, rb);
    xcd_barrier(xb);
    {
      const bfr* A = (const bfr*)(p.ws + R_H);
      const bfr* Wt = (const bfr*)(p.ws + OFF_WF1) + (size_t)l * 2 * FH * D;
      for (int rep = 0; rep < REP_GEMM; ++rep) gemm_phase<EPI_SWIGLU, 4>(p, l, A, D, nullptr, Wt, D, 2 * FH / 128, mt_rows, (float*)(p.ws + R_G), FH, smem);
    }
    xcd_barrier(xb);
    {
      const bfr* A = (const bfr*)(p.ws + R_G);
      const bfr* Wt = (const bfr*)(p.ws + OFF_WF2) + (size_t)l * D * FH;
      for (int rep = 0; rep < REP_GEMM; ++rep) gemm_phase<EPI_F32, 4>(p, l, A, FH, nullptr, Wt, FH, D / 128, mt_rows, (float*)(p.ws + R_F), D, smem);
    }
    xcd_barrier(xb);
    for (int rb = bid; rb < mt_rows / 8; rb += G) rownorm_phase(p, l, 2, rb);
    if (l == 0) xcd_barrier(xb);
  }
}

extern "C" void kernel_launch(void* const* d_in, const int* in_sizes, int n_in, void* d_out, int out_size, void* d_ws, size_t ws_size, hipStream_t stream) {
  static int grid_blocks = 0;
  if (!grid_blocks) {
    int dev = 0, cus = 0, per_cu = 0;
    hipGetDevice(&dev);
    hipDeviceGetAttribute(&cus, hipDeviceAttributeMultiprocessorCount, dev);
    hipOccupancyMaxActiveBlocksPerMultiprocessor(&per_cu, mega, 256, 0);
    if (per_cu > 2) per_cu = 2;
    if (per_cu < 1) per_cu = 1;
    grid_blocks = cus * per_cu;
  }
  if (ws_size < WS_NEED) fprintf(stderr, "workspace too small: %zu < %zu\n", ws_size, (size_t)WS_NEED);
  Params p{};
  for (int i = 0; i < 24; ++i) p.in[i] = (const float*)d_in[i];
  p.out = (float*)d_out;
  p.ws = (char*)d_ws;
  hipMemsetAsync((char*)d_ws + OFF_CNT, 0, 256 + 16384, stream);
  void* args[] = {&p};
  hipError_t e = hipLaunchCooperativeKernel((void*)mega, dim3(grid_blocks), dim3(256), args, 0, stream);
  if (e != hipSuccess) fprintf(stderr, "cooperative launch failed: %s (grid %d)\n", hipGetErrorString(e), grid_blocks);
}
```
